# Optimizing an MI355X kernel written in HIP

```python
import math
import jax, jax.numpy as jnp
from jax import lax
import numpy as np

D_MODEL = 4096
BATCH = 4
SEQ = 4096
DEPTH = 1

N_META = 16
EPS = 1e-6
D_SSM = 1024
SSM_GROUP = 16
N_GROUPS = D_SSM // SSM_GROUP
STATE = 64
DT_MIN = 1e-3
DT_MAX = 1e-1
N_HEADS = 16
HEAD_DIM = 64
V_DIM = 2 * HEAD_DIM
QK_W = N_HEADS * 2 * HEAD_DIM
D_ATT = N_HEADS * V_DIM
Q_BLOCK = 128
PAD = (-N_META) % Q_BLOCK
N_BUCKETS = 32
MAX_DISTANCE = 128
NEG_INF = -1e30
D_FF = -(-8 * D_MODEL // (3 * 256)) * 256
IN_SIZES = (D_SSM, QK_W, QK_W, D_ATT, D_MODEL, D_MODEL)
IN_SPLITS = tuple(int(s) for s in np.cumsum(IN_SIZES)[:-1])
D_IN = sum(IN_SIZES)

kernel_name = "hybrid_s5_diffattn_block"


def rms_norm(x, g):
    xf = x.astype(jnp.float32)
    y = xf * lax.rsqrt(jnp.mean(xf * xf, axis=-1, keepdims=True) + EPS)
    return (y * g.astype(jnp.float32)).astype(x.dtype)


def t5_bucket(n):
    max_exact = N_BUCKETS // 2
    nf = jnp.maximum(n, max_exact).astype(jnp.float32)
    log_b = max_exact + (jnp.log(nf / max_exact) / math.log(MAX_DISTANCE / max_exact)
                         * (N_BUCKETS - max_exact)).astype(jnp.int32)
    return jnp.where(n < max_exact, n, jnp.minimum(log_b, N_BUCKETS - 1))


def _ssm_combine(e1, e2):
    a1, b1 = e1
    a2, b2 = e2
    return a1 * a2, a2 * b1 + b2


def s5_branch(u, lam_re, lam_im, log_dt, b_re, b_im, c_re, c_im, d_skip, w_glu, b_glu):
    f32 = jnp.float32
    bsz, seq_len, _ = u.shape
    lam = lax.complex(lam_re.astype(f32), lam_im.astype(f32))
    dt = jnp.exp(log_dt.astype(f32))[:, None]
    a_bar = jnp.exp(lam * dt)
    b_bar = ((a_bar - 1.0) / lam)[..., None] * lax.complex(b_re.astype(f32), b_im.astype(f32))
    c_mat = lax.complex(c_re.astype(f32), c_im.astype(f32))
    uf = u.astype(f32)
    u_g = uf.reshape(bsz, seq_len, N_GROUPS, SSM_GROUP).astype(jnp.complex64)
    bu = jnp.einsum('gpc,blgc->lbgp', b_bar, u_g)
    a_seq = jnp.broadcast_to(a_bar, (seq_len, 1, N_GROUPS, STATE))
    _, states = lax.associative_scan(_ssm_combine, (a_seq, bu), axis=0)
    y = jnp.real(jnp.einsum('gcp,lbgp->blgc', c_mat, states)).reshape(bsz, seq_len, D_SSM)
    y = y + d_skip.astype(f32) * uf
    g = jax.nn.gelu(y)
    out = g * jax.nn.sigmoid(g @ w_glu.astype(f32) + b_glu.astype(f32))
    return out.astype(u.dtype)


def diff_attention(q, k, v, lam, rel_bias):
    bsz, seq_len = q.shape[:2]
    lp = seq_len + PAD
    n_blocks = lp // Q_BLOCK
    pad = ((0, 0), (PAD, 0), (0, 0), (0, 0), (0, 0))
    q = jnp.pad(q, pad)
    k = jnp.pad(k, pad)
    v = jnp.pad(v, pad[:-1])
    q_blocks = jnp.moveaxis(q.reshape(bsz, n_blocks, Q_BLOCK, N_HEADS, 2, HEAD_DIM), 1, 0)
    key_pos = jnp.arange(lp)
    bias_hd = rel_bias[t5_bucket(key_pos)].T.astype(jnp.float32)
    scale = HEAD_DIM ** -0.5

    def block(args):
        q_blk, blk = args
        q_pos = blk * Q_BLOCK + jnp.arange(Q_BLOCK)
        dist = q_pos[:, None] - key_pos[None, :]
        mask = (dist >= 0) & (key_pos[None, :] >= PAD)
        bias = bias_hd[:, jnp.maximum(dist, 0)]
        s = jnp.einsum('bqhmd,bkhmd->bhmqk', q_blk, k).astype(jnp.float32) * scale + bias[None, :, None]
        p = jax.nn.softmax(jnp.where(mask, s, NEG_INF), axis=-1)
        attn = p[:, :, 0] - lam * p[:, :, 1]
        return jnp.einsum('bhqk,bkhe->bqhe', attn.astype(v.dtype), v)

    out = lax.map(block, (q_blocks, jnp.arange(n_blocks)))
    out = jnp.moveaxis(out, 0, 1).reshape(bsz, lp, N_HEADS, V_DIM)
    return out[:, PAD:]


def setup_inputs(seed: int = 0) -> dict:
    key = jax.random.key(seed)
    ks = jax.random.split(key, 32)
    f32 = jnp.float32

    def nrm(k, shape, scale):
        return jax.random.normal(k, shape, f32) * scale

    def gain(k, shape):
        return 1.0 + 0.01 * jax.random.normal(k, shape, f32)

    lam_im = jnp.pi * jnp.arange(STATE, dtype=f32)[None, None, :] + 0.01 * jax.random.normal(ks[13], (DEPTH, N_GROUPS, STATE), f32)
    w_branch = jnp.concatenate([nrm(ks[22], (DEPTH, D_SSM, D_MODEL), D_SSM ** -0.5),
                                nrm(ks[23], (DEPTH, D_ATT, D_MODEL), D_ATT ** -0.5)], axis=1)
    return {
        "x": nrm(ks[0], (BATCH, SEQ, D_MODEL), 1.0),
        "meta_tokens": nrm(ks[1], (N_META, D_MODEL), 1.0),
        "rel_bias": nrm(ks[2], (N_BUCKETS, N_HEADS), 0.2),
        "ln1_g": gain(ks[3], (DEPTH, D_MODEL)),
        "w_in": nrm(ks[4], (DEPTH, D_MODEL, D_IN), D_MODEL ** -0.5),
        "q_norm_g": gain(ks[5], (DEPTH, HEAD_DIM)),
        "k_norm_g": gain(ks[6], (DEPTH, HEAD_DIM)),
        "lam_q1": nrm(ks[7], (DEPTH, HEAD_DIM), 0.1),
        "lam_k1": nrm(ks[8], (DEPTH, HEAD_DIM), 0.1),
        "lam_q2": nrm(ks[9], (DEPTH, HEAD_DIM), 0.1),
        "lam_k2": nrm(ks[10], (DEPTH, HEAD_DIM), 0.1),
        "subln_g": gain(ks[11], (DEPTH, V_DIM)),
        "lam_re": -0.5 + 0.01 * jax.random.normal(ks[12], (DEPTH, N_GROUPS, STATE), f32),
        "lam_im": lam_im,
        "log_dt": jax.random.uniform(ks[14], (DEPTH, N_GROUPS), f32, math.log(DT_MIN), math.log(DT_MAX)),
        "b_re": nrm(ks[15], (DEPTH, N_GROUPS, STATE, SSM_GROUP), (2 * SSM_GROUP) ** -0.5),
        "b_im": nrm(ks[16], (DEPTH, N_GROUPS, STATE, SSM_GROUP), (2 * SSM_GROUP) ** -0.5),
        "c_re": nrm(ks[17], (DEPTH, N_GROUPS, SSM_GROUP, STATE), STATE ** -0.5),
        "c_im": nrm(ks[18], (DEPTH, N_GROUPS, SSM_GROUP, STATE), STATE ** -0.5),
        "d_skip": nrm(ks[19], (DEPTH, D_SSM), 1.0),
        "w_glu": nrm(ks[20], (DEPTH, D_SSM, D_SSM), D_SSM ** -0.5),
        "b_glu": nrm(ks[21], (DEPTH, D_SSM), 0.01),
        "w_branch": w_branch,
        "w_o": nrm(ks[24], (DEPTH, D_MODEL, D_MODEL), D_MODEL ** -0.5),
        "ln2_g": gain(ks[25], (DEPTH, D_MODEL)),
        "w_gate_up": nrm(ks[26], (DEPTH, D_MODEL, 2 * D_FF), D_MODEL ** -0.5),
        "w_down": nrm(ks[27], (DEPTH, D_FF, D_MODEL), D_FF ** -0.5),
    }


def reference(x, meta_tokens, rel_bias, ln1_g, w_in, q_norm_g, k_norm_g, lam_q1, lam_k1, lam_q2, lam_k2,
              subln_g, lam_re, lam_im, log_dt, b_re, b_im, c_re, c_im, d_skip, w_glu, b_glu,
              w_branch, w_o, ln2_g, w_gate_up, w_down):
    f32 = jnp.float32
    bsz = x.shape[0]
    h = jnp.concatenate([jnp.broadcast_to(meta_tokens[None].astype(x.dtype), (bsz, N_META, D_MODEL)), x], axis=1)
    seq_len = h.shape[1]
    for l in range(DEPTH):
        lambda_init = 0.8 - 0.6 * math.exp(-0.3 * l)
        hn = rms_norm(h, ln1_g[l])
        proj = hn @ w_in[l]
        u, q, k, v, g_ssm, g_att = jnp.split(proj, IN_SPLITS, axis=-1)
        q = rms_norm(q.reshape(bsz, seq_len, N_HEADS, 2, HEAD_DIM), q_norm_g[l])
        k = rms_norm(k.reshape(bsz, seq_len, N_HEADS, 2, HEAD_DIM), k_norm_g[l])
        v = v.reshape(bsz, seq_len, N_HEADS, V_DIM)
        lam = (jnp.exp(jnp.sum(lam_q1[l].astype(f32) * lam_k1[l].astype(f32)))
               - jnp.exp(jnp.sum(lam_q2[l].astype(f32) * lam_k2[l].astype(f32))) + lambda_init)
        o = diff_attention(q, k, v, lam, rel_bias)
        y_att = (rms_norm(o, subln_g[l]) * (1.0 - lambda_init)).reshape(bsz, seq_len, D_ATT)
        y_ssm = s5_branch(u, lam_re[l], lam_im[l], log_dt[l], b_re[l], b_im[l], c_re[l], c_im[l],
                          d_skip[l], w_glu[l], b_glu[l])
        y_a = y_ssm @ w_branch[l, :D_SSM]
        y_b = y_att @ w_branch[l, D_SSM:]
        merged = jax.nn.sigmoid(g_ssm) * y_a + jax.nn.sigmoid(g_att) * y_b
        h = h + merged @ w_o[l]
        hn = rms_norm(h, ln2_g[l])
        gate, up = jnp.split(hn @ w_gate_up[l], 2, axis=-1)
        h = h + (jax.nn.silu(gate) * up) @ w_down[l]
    return h[:, N_META:]
```

```cpp
#include <hip/hip_runtime.h>
#include <hip/hip_bf16.h>
#include <cstdio>
#include <cstdint>
#include <cmath>
namespace pg8 {
#define PG8_LAS __attribute__((address_space(3)))
typedef unsigned short bf16_t;
typedef short bf16x8 __attribute__((ext_vector_type(8)));
typedef float f32x4 __attribute__((ext_vector_type(4)));
typedef unsigned u32x4 __attribute__((ext_vector_type(4)));
constexpr int BM = 256, BK = 64, HALF = 128, HTB = HALF * BK * 2  , STAGE_BYTES = 8 * HTB, NXCD = 8, WGM = 8;

__host__ __device__ __forceinline__ int lds_byte(int r, int c) { const int st = (r >> 4) * 2 + (c >> 5), rr = r & 15, cc = c & 31, ob = rr * 64 + cc * 2; return st * 1024 + (ob ^ (((ob >> 9) & 1) << 5)); }
__host__ __device__ __forceinline__ void stage_rc(int b, int& R, int& C) { const int st = b / 1024, sb = b % 1024, swz = sb ^ (((sb >> 9) & 1) << 5); R = (st >> 1) * 16 + swz / 64; C = (st & 1) * 32 + (swz % 64) / 2; }
__host__ __device__ __forceinline__ int perm32(int rho) { const int n = rho >> 4, i = rho & 15; return 8 * (i >> 2) + 4 * n + (i & 3); }

struct Unit { int pm, pn; };
struct Gemm { const bf16_t* A; const bf16_t* Bt; int M, N, K; };

struct StaticOrder {
    int nM, nN, nwg, G, c;
    __host__ __device__ void init(int M, int N, int G_, int c_) { nM = M / BM; nN = N / BM; nwg = nM * nN; G = G_; c = c_; }
    __host__ __device__ bool next(int i, Unit& u) const {
        const long L = (long)i * G + c; if (L >= nwg) return false;
        int wgid = (int)L; { const int q = nwg / NXCD, r = nwg % NXCD, xcd = wgid % NXCD, off = wgid / NXCD; wgid = (xcd < r ? xcd * (q + 1) : r * (q + 1) + (xcd - r) * q) + off; }
        const int nig = WGM * nN, gid = wgid / nig, fm = gid * WGM, gsz = (nM - fm) < WGM ? (nM - fm) : WGM;
        u.pm = fm + ((wgid % nig) % gsz); u.pn = (wgid % nig) / gsz; return true;
    }
    __device__ __forceinline__ void a_ready(const Unit&) const {}
    __device__ __forceinline__ void done(const Unit&) const {}
};

__device__ __forceinline__ unsigned cvt_pk_bf16(float lo, float hi) { unsigned r; asm volatile("v_cvt_pk_bf16_f32 %0, %1, %2" : "=v"(r) : "v"(lo), "v"(hi)); return r; }
typedef float f32x2 __attribute__((ext_vector_type(2)));
constexpr float kEps = 1e-6f;
constexpr float kQScale = 0.125f * 1.4426950408889634f;
__device__ __forceinline__ float sigm(float x) { return __builtin_amdgcn_rcpf(1.0f + __builtin_amdgcn_exp2f(-1.4426950408889634f * x)); }
__device__ __forceinline__ void unpack8(const u32x4 w, float (&f)[8]) {
    f[0] = __uint_as_float(w.x << 16); f[1] = __uint_as_float(w.x & 0xffff0000u); f[2] = __uint_as_float(w.y << 16); f[3] = __uint_as_float(w.y & 0xffff0000u);
    f[4] = __uint_as_float(w.z << 16); f[5] = __uint_as_float(w.z & 0xffff0000u); f[6] = __uint_as_float(w.w << 16); f[7] = __uint_as_float(w.w & 0xffff0000u);
}
__device__ __forceinline__ u32x4 pack8(const f32x4 a, const f32x4 b) { u32x4 w; w.x = cvt_pk_bf16(a[0], a[1]); w.y = cvt_pk_bf16(a[2], a[3]); w.z = cvt_pk_bf16(b[0], b[1]); w.w = cvt_pk_bf16(b[2], b[3]); return w; }
#define EPI_FENCE() asm volatile("" ::: "memory")

struct EpiInProj {
    static constexpr bool PERM = true, AFTER_DRAIN = false;
    bf16_t *U, *Q, *K, *V, *GS, *GA; const float *qg, *kg;
    __device__ __forceinline__ void operator()(const f32x4 (&acc)[2][2][4][2], const Unit& u, int wr, int wc, int fr, int fq) const {
        const int pn = u.pn; const int row0 = u.pm * BM + wr * 64 + fr;
        const int kvoff = 64 * (u.pm / 16 + 1);
        if (pn >= 4 && pn < 20) {
            const bool isq = pn < 12; const int tile = isq ? pn - 4 : pn - 12;
            bf16_t* base = isq ? Q : K; const float* g = isq ? qg : kg; const float sc = isq ? kQScale : 1.0f; const int roff = isq ? 0 : kvoff;
            f32x4 gv[2][2];
#pragma unroll
            for (int bj = 0; bj < 2; ++bj)
#pragma unroll
                for (int n = 0; n < 2; ++n) gv[bj][n] = *(const f32x4*)(g + 32 * bj + 8 * fq + 4 * n) * sc;
#pragma unroll
            for (int ai = 0; ai < 2; ++ai)
#pragma unroll
                for (int m = 0; m < 4; ++m) {
                    float ss = 0.f;
#pragma unroll
                    for (int bj = 0; bj < 2; ++bj)
#pragma unroll
                        for (int n = 0; n < 2; ++n) { const f32x4 x = acc[ai][bj][m][n]; ss += (x[0] * x[0] + x[1] * x[1]) + (x[2] * x[2] + x[3] * x[3]); }
                    ss += __shfl_xor(ss, 16); ss += __shfl_xor(ss, 32);
                    const float rstd = __builtin_amdgcn_rsqf(ss * (1.0f / 64.0f) + kEps);
                    bf16_t* rowp = base + (size_t)(row0 + ai * HALF + m * 16 + roff) * 2048 + tile * 256 + 64 * wc + 8 * fq;
#pragma unroll
                    for (int bj = 0; bj < 2; ++bj) *(u32x4*)(rowp + 32 * bj) = pack8(acc[ai][bj][m][0] * rstd * gv[bj][0], acc[ai][bj][m][1] * rstd * gv[bj][1]);
                }
            return;
        }
        bf16_t* base; int ldc, colt, roff = 0; bool sg = false;
        if (pn < 4) { base = U; ldc = 1024; colt = pn * BM; }
        else if (pn < 28) { base = V; ldc = 2048; colt = (pn - 20) * BM; roff = kvoff; }
        else if (pn < 44) { base = GS; ldc = 4096; colt = (pn - 28) * BM; sg = true; }
        else { base = GA; ldc = 4096; colt = (pn - 44) * BM; sg = true; }
        const int col0 = colt + wc * 32 + 8 * fq;
#pragma unroll
        for (int ai = 0; ai < 2; ++ai)
#pragma unroll
            for (int m = 0; m < 4; ++m) { bf16_t* rowp = base + (size_t)(row0 + ai * HALF + m * 16 + roff) * ldc + col0;
#pragma unroll
                for (int bj = 0; bj < 2; ++bj) { f32x4 v0 = acc[ai][bj][m][0], v1 = acc[ai][bj][m][1];
                    if (sg) {
#pragma unroll
                        for (int e = 0; e < 4; ++e) { v0[e] = sigm(v0[e]); v1[e] = sigm(v1[e]); } }
                    *(u32x4*)(rowp + bj * HALF) = pack8(v0, v1); } }
    }
};
struct EpiGlu {
    static constexpr bool PERM = true, AFTER_DRAIN = false;
    const bf16_t* G; const float* bias; bf16_t* Y;
    __device__ __forceinline__ void operator()(const f32x4 (&acc)[2][2][4][2], const Unit& u, int wr, int wc, int fr, int fq) const {
        const int row0 = u.pm * BM + wr * 64 + fr, col0 = u.pn * BM + wc * 32 + 8 * fq;
        f32x4 bv[2][2];
#pragma unroll
        for (int bj = 0; bj < 2; ++bj)
#pragma unroll
            for (int n = 0; n < 2; ++n) bv[bj][n] = *(const f32x4*)(bias + col0 + bj * HALF + 4 * n);
#pragma unroll
        for (int ai = 0; ai < 2; ++ai)
#pragma unroll
            for (int m = 0; m < 4; ++m) { const size_t off = (size_t)(row0 + ai * HALF + m * 16) * 1024 + col0;
#pragma unroll
                for (int bj = 0; bj < 2; ++bj) { float g[8]; unpack8(*(const u32x4*)(G + off + bj * HALF), g);
                    f32x4 v0 = acc[ai][bj][m][0] + bv[bj][0], v1 = acc[ai][bj][m][1] + bv[bj][1];
#pragma unroll
                    for (int e = 0; e < 4; ++e) { v0[e] = g[e] * sigm(v0[e]); v1[e] = g[4 + e] * sigm(v1[e]); }
                    *(u32x4*)(Y + off + bj * HALF) = pack8(v0, v1); }
                EPI_FENCE(); }
    }
};
template <bool FIRST> struct EpiBranch {
    static constexpr bool PERM = true, AFTER_DRAIN = false;
    const bf16_t* GATE; bf16_t* T;
    __device__ __forceinline__ void operator()(const f32x4 (&acc)[2][2][4][2], const Unit& u, int wr, int wc, int fr, int fq) const {
        const int row0 = u.pm * BM + wr * 64 + fr, col0 = u.pn * BM + wc * 32 + 8 * fq;
#pragma unroll
        for (int ai = 0; ai < 2; ++ai)
#pragma unroll
            for (int m = 0; m < 4; ++m) { const size_t off = (size_t)(row0 + ai * HALF + m * 16) * 4096 + col0;
#pragma unroll
                for (int bj = 0; bj < 2; ++bj) { float g[8]; unpack8(*(const u32x4*)(GATE + off + bj * HALF), g);
                    f32x4 v0 = acc[ai][bj][m][0], v1 = acc[ai][bj][m][1];
                    if (FIRST) {
#pragma unroll
                        for (int e = 0; e < 4; ++e) { v0[e] *= g[e]; v1[e] *= g[4 + e]; }
                    } else { float t[8]; unpack8(*(const u32x4*)(T + off + bj * HALF), t);
#pragma unroll
                        for (int e = 0; e < 4; ++e) { v0[e] = t[e] + v0[e] * g[e]; v1[e] = t[4 + e] + v1[e] * g[4 + e]; } }
                    *(u32x4*)(T + off + bj * HALF) = pack8(v0, v1); }
                EPI_FENCE(); }
    }
};
struct EpiOut {
    static constexpr bool PERM = true, AFTER_DRAIN = false;
    const float* X; float* H; bf16_t* HB; float* PS;
    __device__ __forceinline__ void operator()(const f32x4 (&acc)[2][2][4][2], const Unit& u, int wr, int wc, int fr, int fq) const {
        const int row0 = u.pm * BM + wr * 64 + fr, col0 = u.pn * BM + wc * 32 + 8 * fq;
#pragma unroll
        for (int ai = 0; ai < 2; ++ai)
#pragma unroll
            for (int m = 0; m < 4; ++m) { const int row = row0 + ai * HALF + m * 16; const size_t off = (size_t)row * 4096 + col0; float ss = 0.f;
#pragma unroll
                for (int bj = 0; bj < 2; ++bj) { const f32x4 x0 = *(const f32x4*)(X + off + bj * HALF), x1 = *(const f32x4*)(X + off + bj * HALF + 4);
                    const f32x4 v0 = acc[ai][bj][m][0] + x0, v1 = acc[ai][bj][m][1] + x1;
                    ss += (v0[0] * v0[0] + v0[1] * v0[1]) + (v0[2] * v0[2] + v0[3] * v0[3]) + (v1[0] * v1[0] + v1[1] * v1[1]) + (v1[2] * v1[2] + v1[3] * v1[3]);
                    *(f32x4*)(H + off + bj * HALF) = v0; *(f32x4*)(H + off + bj * HALF + 4) = v1;
                    *(u32x4*)(HB + off + bj * HALF) = pack8(v0, v1); }
                ss += __shfl_xor(ss, 16); ss += __shfl_xor(ss, 32);
                if (fq == 0) PS[(size_t)row * 64 + u.pn * 4 + wc] = ss;
                EPI_FENCE(); }
    }
};
struct EpiGateUp {
    static constexpr bool PERM = true, AFTER_DRAIN = false;
    const float* PS; bf16_t* ACT;
    __device__ __forceinline__ void operator()(const f32x4 (&acc)[2][2][4][2], const Unit& u, int wr, int wc, int fr, int fq) const {
        const int row0 = u.pm * BM + wr * 64 + fr, col0 = u.pn * HALF + wc * 32 + 8 * fq;
#pragma unroll
        for (int ai = 0; ai < 2; ++ai)
#pragma unroll
            for (int m = 0; m < 4; ++m) { const int row = row0 + ai * HALF + m * 16;
                const f32x4* ps = (const f32x4*)(PS + (size_t)row * 64 + fq * 16);
                const f32x4 p0 = ps[0], p1 = ps[1], p2 = ps[2], p3 = ps[3];
                float ss = ((p0[0] + p0[1]) + (p0[2] + p0[3])) + ((p1[0] + p1[1]) + (p1[2] + p1[3])) + ((p2[0] + p2[1]) + (p2[2] + p2[3])) + ((p3[0] + p3[1]) + (p3[2] + p3[3]));
                ss += __shfl_xor(ss, 16); ss += __shfl_xor(ss, 32);
                const float r = __builtin_amdgcn_rsqf(ss * (1.0f / 4096.0f) + kEps);
                f32x4 v0, v1;
#pragma unroll
                for (int e = 0; e < 4; ++e) { const float g0 = acc[ai][0][m][0][e] * r, u0 = acc[ai][1][m][0][e] * r, g1 = acc[ai][0][m][1][e] * r, u1 = acc[ai][1][m][1][e] * r;
                    v0[e] = g0 * sigm(g0) * u0; v1[e] = g1 * sigm(g1) * u1; }
                *(u32x4*)(ACT + (size_t)row * 11008 + col0) = pack8(v0, v1);
                EPI_FENCE(); }
    }
};
struct EpiDown {
    static constexpr bool PERM = true, AFTER_DRAIN = false;
    float* H;
    __device__ __forceinline__ void operator()(const f32x4 (&acc)[2][2][4][2], const Unit& u, int wr, int wc, int fr, int fq) const {
        const int row0 = u.pm * BM + wr * 64 + fr, col0 = u.pn * BM + wc * 32 + 8 * fq;
#pragma unroll
        for (int ai = 0; ai < 2; ++ai)
#pragma unroll
            for (int m = 0; m < 4; ++m) { const size_t off = (size_t)(row0 + ai * HALF + m * 16) * 4096 + col0;
#pragma unroll
                for (int bj = 0; bj < 2; ++bj) { f32x4* p = (f32x4*)(H + off + bj * HALF); const f32x4 x0 = p[0], x1 = p[1];
                    p[0] = acc[ai][bj][m][0] + x0; p[1] = acc[ai][bj][m][1] + x1; }
                EPI_FENCE(); }
    }
};
template <class Epi, class Sched, bool ALIGN_EPI = false, bool SP2 = false>
__device__ __forceinline__ void gemm_phase(PG8_LAS unsigned char* lds, const Gemm g, const Sched& S, const Epi& E) {
    const int tid = threadIdx.x, wid = __builtin_amdgcn_readfirstlane(tid >> 6), lane = tid & 63, wr = wid >> 2, wc = wid & 3, fr = lane & 15, fq = lane >> 4;
    const int K = g.K, nt = K / BK;
    unsigned voffA[2], voffB[2];
#pragma unroll
    for (int i = 0; i < 2; ++i) { int R, C; stage_rc(tid * 16 + i * 8192, R, C); const int Rb = Epi::PERM ? ((R & ~31) + perm32(R & 31)) : R;
        voffA[i] = (unsigned)(R * K + C) * 2u; voffB[i] = (unsigned)(Rb * K + C) * 2u; }
    const size_t kstep = (size_t)(BK * 2);
    const size_t hstep = (size_t)HALF * K * 2;
    const size_t tstep = 2 * hstep;
    const unsigned ldsw = (unsigned)wid * 1024u;
    const int aoff = lds_byte(wr * 64 + fr, fq * 8), boff = lds_byte(wc * 32 + fr, fq * 8);
#define PG8_SA(b, h) (((b) * 2 + (h)) * HTB)
#define PG8_SB(b, h) ((4 + (b) * 2 + (h)) * HTB)
#define PG8_STAGE(bufoff, gbase, voff) do { _Pragma("unroll") for (int _i = 0; _i < 2; ++_i) \
        __builtin_amdgcn_global_load_lds((const unsigned*)((const char*)(gbase) + (voff)[_i]), (PG8_LAS unsigned*)(lds + (bufoff) + ldsw + _i * 8192), 16, 0, 0); } while (0)
#define PG8_LDA(dst, b, h) do { _Pragma("unroll") for (int m = 0; m < 4; ++m) _Pragma("unroll") for (int k = 0; k < 2; ++k) dst[m][k] = *(const PG8_LAS bf16x8*)(lds + PG8_SA(b, h) + aoff + m * 2048 + k * 1024); } while (0)
#define PG8_LDB(dst, b, h) do { _Pragma("unroll") for (int n = 0; n < 2; ++n) _Pragma("unroll") for (int k = 0; k < 2; ++k) dst[n][k] = *(const PG8_LAS bf16x8*)(lds + PG8_SB(b, h) + boff + n * 2048 + k * 1024); } while (0)
#define PG8_MMA(ai, bj, At, Bt) do { __builtin_amdgcn_s_setprio(1); _Pragma("unroll") for (int m = 0; m < 4; ++m) _Pragma("unroll") for (int n = 0; n < 2; ++n) _Pragma("unroll") for (int k = 0; k < 2; ++k) \
        acc[ai][bj][m][n] = __builtin_amdgcn_mfma_f32_16x16x32_bf16(Bt[n][k], At[m][k], acc[ai][bj][m][n], 0, 0, 0); __builtin_amdgcn_s_setprio(0); } while (0)
#define PG8_WAIT_V(n) asm volatile("s_waitcnt vmcnt(" #n ")" ::: "memory")
#define PG8_WAIT_L(n) asm volatile("s_waitcnt lgkmcnt(" #n ")" ::: "memory")
#define PG8_BAR __builtin_amdgcn_s_barrier()
#define PG8_SCHED __builtin_amdgcn_sched_barrier(0)
    Unit cur, nxt; int ui = 0;
    if (!S.next(0, cur)) return;
    f32x4 acc[2][2][4][2];
#pragma unroll
    for (int a = 0; a < 2; ++a)
#pragma unroll
        for (int b = 0; b < 2; ++b)
#pragma unroll
            for (int m = 0; m < 4; ++m)
#pragma unroll
                for (int n = 0; n < 2; ++n) acc[a][b][m][n] = (f32x4){0.f, 0.f, 0.f, 0.f};
    bf16x8 At[4][2], B0[2][2], B1[2][2];
    const char* cA = (const char*)g.A + (size_t)cur.pm * tstep; const char* cB = (const char*)g.Bt + (size_t)cur.pn * tstep;
    S.a_ready(cur);
    if constexpr (SP2) {
        PG8_STAGE(PG8_SB(0, 0), cB, voffB); PG8_STAGE(PG8_SB(0, 1), cB + hstep, voffB); PG8_STAGE(PG8_SA(0, 0), cA, voffA); PG8_STAGE(PG8_SA(0, 1), cA + hstep, voffA);
        if (wr == 1) PG8_BAR;
        PG8_WAIT_V(2); PG8_BAR;
        PG8_STAGE(PG8_SB(1, 0), cB + kstep, voffB); PG8_STAGE(PG8_SA(1, 0), cA + kstep, voffA); PG8_STAGE(PG8_SB(1, 1), cB + hstep + kstep, voffB);
        PG8_WAIT_V(6); PG8_BAR;
    } else {
        PG8_STAGE(PG8_SB(0, 0), cB, voffB); PG8_STAGE(PG8_SA(0, 0), cA, voffA); PG8_STAGE(PG8_SB(0, 1), cB + hstep, voffB); PG8_STAGE(PG8_SA(0, 1), cA + hstep, voffA);
        if (wr == 1) PG8_BAR;
        PG8_WAIT_V(4); PG8_BAR;
        PG8_STAGE(PG8_SB(1, 0), cB + kstep, voffB); PG8_STAGE(PG8_SA(1, 0), cA + kstep, voffA); PG8_STAGE(PG8_SB(1, 1), cB + hstep + kstep, voffB);
        PG8_WAIT_V(6); PG8_BAR;
    }
    for (;;) {
        const bool has_next = S.next(ui + 1, nxt);
        const char* nA = has_next ? (const char*)g.A + (size_t)nxt.pm * tstep : cA; const char* nB = has_next ? (const char*)g.Bt + (size_t)nxt.pn * tstep : cB;
        for (int t = 0; t < nt; t += 2) {
            const bool last = (t == nt - 2);
            const char* a1 = cA + (size_t)(t + 1) * kstep;
            const char* a2 = last ? nA : cA + (size_t)(t + 2) * kstep; const char* b2 = last ? nB : cB + (size_t)(t + 2) * kstep;
            const char* a3 = a2 + kstep; const char* b3 = b2 + kstep;
            if (last && has_next) S.a_ready(nxt);
            if constexpr (SP2) {
            PG8_LDB(B0, 0, 0); PG8_LDB(B1, 0, 1); PG8_SCHED; PG8_LDA(At, 0, 0); PG8_STAGE(PG8_SA(1, 1), a1 + hstep, voffA);
            PG8_WAIT_V(8); PG8_WAIT_L(0); PG8_BAR; PG8_MMA(0, 0, At, B0); PG8_MMA(0, 1, At, B1); PG8_BAR; PG8_SCHED;
            PG8_LDA(At, 0, 1); PG8_STAGE(PG8_SB(0, 0), b2, voffB); PG8_STAGE(PG8_SB(0, 1), b2 + hstep, voffB); PG8_STAGE(PG8_SA(0, 0), a2, voffA);
            PG8_WAIT_V(8); PG8_WAIT_L(0); PG8_BAR; PG8_MMA(1, 0, At, B0); PG8_MMA(1, 1, At, B1); PG8_BAR; PG8_SCHED;
            PG8_LDB(B0, 1, 0); PG8_LDB(B1, 1, 1); PG8_SCHED; PG8_LDA(At, 1, 0); PG8_STAGE(PG8_SA(0, 1), a2 + hstep, voffA);
            PG8_WAIT_V(8); PG8_WAIT_L(0); PG8_BAR; PG8_MMA(0, 0, At, B0); PG8_MMA(0, 1, At, B1); PG8_BAR; PG8_SCHED;
            PG8_LDA(At, 1, 1); PG8_STAGE(PG8_SB(1, 0), b3, voffB); PG8_STAGE(PG8_SB(1, 1), b3 + hstep, voffB); PG8_STAGE(PG8_SA(1, 0), a3, voffA);
            PG8_WAIT_V(8); PG8_WAIT_L(0); PG8_BAR; PG8_MMA(1, 0, At, B0); PG8_MMA(1, 1, At, B1); PG8_BAR; PG8_SCHED;
            } else {
            PG8_LDB(B0, 0, 0); PG8_SCHED; PG8_LDA(At, 0, 0); PG8_STAGE(PG8_SA(1, 1), a1 + hstep, voffA);
            PG8_WAIT_L(8); PG8_BAR; PG8_WAIT_L(0); PG8_MMA(0, 0, At, B0); PG8_BAR; PG8_SCHED;
            PG8_LDB(B1, 0, 1); PG8_STAGE(PG8_SB(0, 0), b2, voffB);
            PG8_BAR; PG8_WAIT_L(0); PG8_MMA(0, 1, At, B1); PG8_BAR;
            PG8_LDA(At, 0, 1); PG8_STAGE(PG8_SA(0, 0), a2, voffA);
            PG8_BAR; PG8_WAIT_L(0); PG8_MMA(1, 0, At, B0); PG8_BAR; PG8_SCHED;
            PG8_STAGE(PG8_SB(0, 1), b2 + hstep, voffB);
            PG8_WAIT_V(6); PG8_BAR; PG8_MMA(1, 1, At, B1); PG8_BAR;
            PG8_LDB(B0, 1, 0); PG8_SCHED; PG8_LDA(At, 1, 0); PG8_STAGE(PG8_SA(0, 1), a2 + hstep, voffA);
            PG8_WAIT_L(8); PG8_BAR; PG8_WAIT_L(0); PG8_MMA(0, 0, At, B0); PG8_BAR; PG8_SCHED;
            PG8_LDB(B1, 1, 1); PG8_STAGE(PG8_SB(1, 0), b3, voffB);
            PG8_BAR; PG8_WAIT_L(0); PG8_MMA(0, 1, At, B1); PG8_BAR;
            PG8_LDA(At, 1, 1); PG8_STAGE(PG8_SA(1, 0), a3, voffA);
            PG8_BAR; PG8_WAIT_L(0); PG8_MMA(1, 0, At, B0); PG8_BAR; PG8_SCHED;
            PG8_STAGE(PG8_SB(1, 1), b3 + hstep, voffB);
            PG8_WAIT_V(6); PG8_BAR; PG8_MMA(1, 1, At, B1); PG8_BAR;
            }
        }
        if constexpr (ALIGN_EPI) { if (wr == 0) PG8_BAR; }
        if constexpr (!Epi::AFTER_DRAIN) { E(acc, cur, wr, wc, fr, fq); S.done(cur); }
        if (!has_next) break;
#pragma unroll
        for (int a = 0; a < 2; ++a)
#pragma unroll
            for (int b = 0; b < 2; ++b)
#pragma unroll
                for (int m = 0; m < 4; ++m)
#pragma unroll
                    for (int n = 0; n < 2; ++n) acc[a][b][m][n] = (f32x4){0.f, 0.f, 0.f, 0.f};
        cur = nxt; cA = nA; cB = nB; ++ui;
        if constexpr (ALIGN_EPI) { if (wr == 1) PG8_BAR; }
    }
    PG8_WAIT_V(0);
    if constexpr (!ALIGN_EPI) { if (wr == 0) PG8_BAR; }
    PG8_BAR;
    if constexpr (Epi::AFTER_DRAIN) { E.fused(acc, cur, wr, wc, fr, fq, lds, wid, lane); S.done(cur); }
#undef PG8_SA
#undef PG8_SB
#undef PG8_STAGE
#undef PG8_LDA
#undef PG8_LDB
#undef PG8_MMA
#undef PG8_WAIT_V
#undef PG8_WAIT_L
#undef PG8_BAR
#undef PG8_SCHED
}
}

#ifndef PG8_SP2
#define PG8_SP2 true
#endif
#ifndef PG8_ALIGN
#define PG8_ALIGN true
#endif
constexpr int NWAVES = 8;
#ifndef MK_N_LAUNCHES
#define MK_N_LAUNCHES 1
#endif
constexpr int N_PHASES = 8;
constexpr int N_LAUNCHES = MK_N_LAUNCHES;

constexpr int BATCH = 4, SEQ = 4096, D = 4096, NMETA = 16;
constexpr int M = BATCH * SEQ;
constexpr int D_SSM = 1024, NGRP = 64, SGRP = 16, NSTATE = 64;
constexpr int NH = 16, HD = 64, VD = 128, QKW = 2048, DATT = 2048;
constexpr int D_IN = 15360, D_FF = 11008;
constexpr int KVROWS = SEQ + 64;
constexpr float EPS = 1e-6f;
constexpr float LAMBDA_INIT = 0.2f;
constexpr float LOG2E = 1.4426950408889634f;

constexpr size_t MiB = 1u << 20;
constexpr size_t WS_CTL = 0, CTL_ZERO_BYTES = 1 * MiB;
constexpr size_t WS_WIN = 2 * MiB, WS_WGLU = 122 * MiB, WS_WBRA = 124 * MiB, WS_WBRB = 132 * MiB, WS_WO = 148 * MiB, WS_WGU = 180 * MiB, WS_WDN = 352 * MiB;
constexpr size_t WS_HN = 438 * MiB;
constexpr size_t WS_TM = 566 * MiB;
constexpr size_t WS_U = 694 * MiB, WS_Q = 726 * MiB, WS_K = 790 * MiB, WS_V = 855 * MiB, WS_GS = 920 * MiB, WS_GA = 1048 * MiB;
constexpr size_t WS_ACT = 694 * MiB;
constexpr size_t WS_G = 1176 * MiB, WS_YSSM = 1208 * MiB;
constexpr size_t WS_PS = 1240 * MiB;
constexpr size_t WS_HNM = 1244 * MiB, WS_UM = 1245 * MiB;
constexpr size_t WS_END = 1290 * MiB;
static_assert(WS_WIN + (size_t)D_IN * D * 2 <= WS_WGLU && WS_WGU + (size_t)2 * D_FF * D * 2 <= WS_WDN && WS_WDN + (size_t)D * D_FF * 2 <= WS_HN, "weights map");
static_assert(WS_K + (size_t)BATCH * KVROWS * QKW * 2 <= WS_V && WS_V + (size_t)BATCH * KVROWS * DATT * 2 <= WS_GS && WS_ACT + (size_t)M * D_FF * 2 <= WS_GA, "activation map");
constexpr int CW_TMO = 0, CW_CODE = 1;
constexpr int CW_BAR = 4096;

constexpr int RING_OFF = 0, RING_BYTES = 131072;
constexpr int LDSCTL_OFF = RING_BYTES, MISC_OFF = LDSCTL_OFF + 320;
constexpr int LDS_BYTES = 147456;
static_assert(MISC_OFF + 128 <= LDS_BYTES, "LDS map");
#define GAS __attribute__((address_space(1)))
#define LAS __attribute__((address_space(3)))
typedef unsigned short bf16;
typedef unsigned v4u __attribute__((ext_vector_type(4)));
typedef float f32x4 __attribute__((ext_vector_type(4)));
typedef short bf16x8 __attribute__((ext_vector_type(8)));
typedef GAS unsigned gu32;
typedef GAS unsigned long long gu64;
#define RLX_AGENT __ATOMIC_RELAXED, __HIP_MEMORY_SCOPE_AGENT
#define LDS_WAIT() asm volatile("s_waitcnt lgkmcnt(0)" ::: "memory")
#define VM_WAIT() asm volatile("s_waitcnt vmcnt(0)" ::: "memory")
__device__ __forceinline__ unsigned long long rt() { return __builtin_amdgcn_s_memrealtime(); }
__device__ __forceinline__ unsigned f2bf(float f) { unsigned u = __builtin_bit_cast(unsigned, f); return (u + 0x7fffu + ((u >> 16) & 1u)) >> 16; }
__device__ __forceinline__ unsigned pk2(float lo, float hi) { return f2bf(lo) | (f2bf(hi) << 16); }

#define XB_TMO      128
#define XB_XCNT(j)  (256  + 64 * (j))
#define XB_XSUB(j)  (1280 + 64 * (j))
#define XB_XGEN(j)  (2304 + 64 * (j))
#define XB_TOP      3328
#define XB_TOPGEN   3392
#define XCD_BAR_WORDS 3456
#define XB_SPIN_CAP (1u << 18)

__device__ __forceinline__ unsigned xb_ld(unsigned* p)              { return __hip_atomic_load(p, __ATOMIC_RELAXED, __HIP_MEMORY_SCOPE_AGENT); }
__device__ __forceinline__ unsigned xb_add(unsigned* p, unsigned v) { return __hip_atomic_fetch_add(p, v, __ATOMIC_RELAXED, __HIP_MEMORY_SCOPE_AGENT); }
__device__ __forceinline__ unsigned xb_xcc_id() { return (unsigned)__builtin_amdgcn_s_getreg((3 << 11) | 20) & 0xFu; }
#define XB_SPIN(cond, bar) do { unsigned _sp = 0; while (cond) { __builtin_amdgcn_s_sleep(1); \
    if ((++_sp & 255u) == 0u) { if (xb_ld(&(bar)[XB_TMO])) break; if (_sp > XB_SPIN_CAP) { atomicAdd(&(bar)[XB_TMO], 1u); break; } } } } while (0)

struct XcdBarrier {
    unsigned* bar; unsigned x;
    volatile LAS unsigned* st;
};

__device__ __forceinline__ XcdBarrier xcd_barrier_post(unsigned* bar, volatile LAS unsigned* st) {
    XcdBarrier b; b.bar = bar; b.x = xb_xcc_id(); b.st = st;
    if (threadIdx.x == 0) (void)xb_add(&bar[XB_XCNT(b.x)], 1u);
    return b;
}
__device__ __forceinline__ void xcd_barrier_complete(unsigned* bar, unsigned x, unsigned& nloc, unsigned& nx) {
    const unsigned G = gridDim.x * gridDim.y * gridDim.z;
    unsigned sum, cnt, mine, sp = 0u;
    for (;;) {
        sum = 0u; cnt = 0u; mine = 0u;
#pragma unroll
        for (unsigned j = 0; j < 16; ++j) { const unsigned c = xb_ld(&bar[XB_XCNT(j)]); sum += c; cnt += (c > 0u) ? 1u : 0u; mine = (j == x) ? c : mine; }
        if (sum == G) break;
        __builtin_amdgcn_s_sleep(1);
        if ((++sp & 255u) == 0u) { if (xb_ld(&bar[XB_TMO])) break; if (sp > XB_SPIN_CAP) { atomicAdd(&bar[XB_TMO], 1u); break; } }
    }
    nloc = mine > 0u ? mine : 1u; nx = cnt > 0u ? cnt : 1u;
}

__device__ __forceinline__ void xcd_barrier(const XcdBarrier& b) {
    asm volatile("s_waitcnt vmcnt(0)" ::: "memory");
    __syncthreads();
    if (threadIdx.x == 0) {
        unsigned* bar = b.bar;
        __builtin_amdgcn_s_waitcnt(0);
        unsigned nloc = b.st[0], nx = b.st[1];
        if (nloc == 0u) { xcd_barrier_complete(bar, b.x, nloc, nx); b.st[0] = nloc; b.st[1] = nx; }
        const unsigned old = xb_add(&bar[XB_XSUB(b.x)], 1u);
        const unsigned gen = old / nloc;
        if (old + 1u == (gen + 1u) * nloc) {
            __builtin_amdgcn_fence(__ATOMIC_RELEASE, "agent");
            asm volatile("s_waitcnt vmcnt(0)" ::: "memory");
            const unsigned og = xb_add(&bar[XB_TOP], 1u);
            const unsigned tg = og / nx;
            if (og + 1u == (tg + 1u) * nx) xb_add(&bar[XB_TOPGEN], 1u);
            else XB_SPIN(xb_ld(&bar[XB_TOPGEN]) == tg, bar);
            __builtin_amdgcn_fence(__ATOMIC_ACQUIRE, "agent");
            xb_add(&bar[XB_XGEN(b.x)], 1u);
            asm volatile("s_waitcnt vmcnt(0)" ::: "memory");
        } else {
            XB_SPIN(xb_ld(&bar[XB_XGEN(b.x)]) == gen, bar);
            __builtin_amdgcn_fence(__ATOMIC_ACQUIRE, "agent");
            asm volatile("s_waitcnt vmcnt(0)" ::: "memory");
        }
    }
    __syncthreads();
}
struct Frame {
    LAS unsigned char* lds;
    volatile LAS unsigned* MISC;
    gu32* ctl;
    int tid, lane, wave;
    int vcu, G;
    const float* in[27]; float* out; unsigned char* ws;
    bf16 *WinT, *WgluT, *WbraT, *WbrbT, *WoT, *WguT, *WdnT;
    bf16 *HN, *TM, *U, *Q, *K, *V, *GS, *GA, *ACT, *Gb, *YSSM, *HNM, *UM; float* PS;
};
enum { I_X = 0, I_META, I_RELB, I_LN1G, I_WIN, I_QG, I_KG, I_LQ1, I_LK1, I_LQ2, I_LK2, I_SUBG, I_LRE, I_LIM, I_LOGDT, I_BRE, I_BIM, I_CRE, I_CIM, I_DSKIP, I_WGLU, I_BGLU, I_WBR, I_WO, I_LN2G, I_WGU, I_WDN };

__device__ __forceinline__ float wave_sum(float v) {
#pragma unroll
    for (int o = 1; o < 64; o <<= 1) v += __shfl_xor(v, o);
    return v;
}
__device__ __forceinline__ float wave_max(float v) {
#pragma unroll
    for (int o = 1; o < 64; o <<= 1) v = fmaxf(v, __shfl_xor(v, o));
    return v;
}
__device__ __forceinline__ float bf_lo(unsigned w) { return __uint_as_float(w << 16); }
__device__ __forceinline__ float bf_hi(unsigned w) { return __uint_as_float(w & 0xffff0000u); }

enum { RM_ID = 0, RM_IN = 1, RM_GU = 2 };
__device__ __forceinline__ int rowmap(int mode, int n) {
    if (mode == RM_IN) { if (n >= 1024 && n < 5120) { const int base = n - 1024, tile = base >> 8, c = base & 255, w = c >> 6, i = c & 63; return 1024 + tile * 256 + (i >> 5) * 128 + w * 32 + (i & 31); } return n; }
    if (mode == RM_GU) { const int up = n >= D_FF ? 1 : 0; const int j = up ? n - D_FF : n; return (j >> 7) * 256 + up * 128 + (j & 127); }
    return n;
}
__device__ __forceinline__ void p0_transpose_item(const float* W, int K, int N, bf16* WT, int mode, const float* ksc, LAS float* scr, int item, int lane) {
    const int nblk = N / 32, kb = item / nblk, nb = item % nblk, k0 = 64 * kb, n0 = 32 * nb;
#pragma unroll 8
    for (int i = 0; i < 32; ++i) { const int kk = 2 * i + (lane >> 5); float v = W[(size_t)(k0 + kk) * N + n0 + (lane & 31)]; if (ksc) v *= ksc[k0 + kk]; scr[kk * 33 + (lane & 31)] = v; }
    LDS_WAIT(); asm volatile("" ::: "memory");
    const int c = lane & 7;
#pragma unroll
    for (int j = 0; j < 4; ++j) { const int n = (lane >> 3) + 8 * j; const LAS float* s = scr + (8 * c) * 33 + n;
        v4u o; o.x = pk2(s[0 * 33], s[1 * 33]); o.y = pk2(s[2 * 33], s[3 * 33]); o.z = pk2(s[4 * 33], s[5 * 33]); o.w = pk2(s[6 * 33], s[7 * 33]);
        *(GAS v4u*)(WT + (size_t)rowmap(mode, n0 + n) * K + k0 + 8 * c) = o; }
    LDS_WAIT(); asm volatile("" ::: "memory");
}
__device__ __forceinline__ void rms_row_to_bf16(const float* xrow, const float* g, bf16* orow, int lane) {
    f32x4 v[8][2]; float s = 0.f;
#pragma unroll
    for (int j = 0; j < 8; ++j) { const GAS f32x4* p = (const GAS f32x4*)(xrow + 512 * j + 8 * lane); v[j][0] = p[0]; v[j][1] = p[1];
        s += ((v[j][0].x * v[j][0].x + v[j][0].y * v[j][0].y) + (v[j][0].z * v[j][0].z + v[j][0].w * v[j][0].w)) + ((v[j][1].x * v[j][1].x + v[j][1].y * v[j][1].y) + (v[j][1].z * v[j][1].z + v[j][1].w * v[j][1].w)); }
    const float r = 1.0f / sqrtf(wave_sum(s) * (1.0f / D) + EPS);
#pragma unroll
    for (int j = 0; j < 8; ++j) { const GAS f32x4* gp = (const GAS f32x4*)(g + 512 * j + 8 * lane); const f32x4 a = v[j][0] * r * gp[0], b = v[j][1] * r * gp[1];
        v4u o; o.x = pk2(a.x, a.y); o.y = pk2(a.z, a.w); o.z = pk2(b.x, b.y); o.w = pk2(b.z, b.w);
        *(GAS v4u*)(orow + 512 * j + 8 * lane) = o; }
}
__device__ __forceinline__ void p0_prologue(Frame& F) {
    LAS float* scr = (LAS float*)(F.lds + RING_OFF + F.wave * 16384);
    const int gw = F.vcu * NWAVES + F.wave, NGW = F.G * NWAVES;
    constexpr int I_IN = (D / 64) * (D_IN / 32), I_GLU = (D_SSM / 64) * (D_SSM / 32), I_BRA = (D_SSM / 64) * (D / 32), I_BRB = (DATT / 64) * (D / 32), I_O = (D / 64) * (D / 32),
                  I_GU = (D / 64) * (2 * D_FF / 32), I_DN = (D_FF / 64) * (D / 32);
    constexpr int NITEMS = I_IN + I_GLU + I_BRA + I_BRB + I_O + I_GU + I_DN;
    for (int it = gw; it < NITEMS; it += NGW) {
        int r = it;
        if (r < I_IN) { p0_transpose_item(F.in[I_WIN], D, D_IN, F.WinT, RM_IN, nullptr, scr, r, F.lane); continue; } r -= I_IN;
        if (r < I_GLU) { p0_transpose_item(F.in[I_WGLU], D_SSM, D_SSM, F.WgluT, RM_ID, nullptr, scr, r, F.lane); continue; } r -= I_GLU;
        if (r < I_BRA) { p0_transpose_item(F.in[I_WBR], D_SSM, D, F.WbraT, RM_ID, nullptr, scr, r, F.lane); continue; } r -= I_BRA;
        if (r < I_BRB) { p0_transpose_item(F.in[I_WBR] + (size_t)D_SSM * D, DATT, D, F.WbrbT, RM_ID, nullptr, scr, r, F.lane); continue; } r -= I_BRB;
        if (r < I_O) { p0_transpose_item(F.in[I_WO], D, D, F.WoT, RM_ID, nullptr, scr, r, F.lane); continue; } r -= I_O;
        if (r < I_GU) { p0_transpose_item(F.in[I_WGU], D, 2 * D_FF, F.WguT, RM_GU, F.in[I_LN2G], scr, r, F.lane); continue; } r -= I_GU;
        p0_transpose_item(F.in[I_WDN], D_FF, D, F.WdnT, RM_ID, nullptr, scr, r, F.lane);
    }
    for (int m = gw; m < M + NMETA; m += NGW) {
        if (m < M) rms_row_to_bf16(F.in[I_X] + (size_t)m * D, F.in[I_LN1G], F.HN + (size_t)m * D, F.lane);
        else rms_row_to_bf16(F.in[I_META] + (size_t)(m - M) * D, F.in[I_LN1G], F.HNM + (size_t)(m - M) * D, F.lane);
    }
}

__device__ __forceinline__ void meta_proj(Frame& F) {
    const int t = blockIdx.x;
    if (t < 80) {
        const int lane = F.lane, w = F.wave, l15 = lane & 15, kq = lane >> 4;
        const int type = t < 16 ? 0 : (t < 48 ? 1 : 2), Gi = t - (type == 0 ? 0 : (type == 1 ? 16 : 48));
        const bf16* arow[4];
#pragma unroll
        for (int sb = 0; sb < 4; ++sb) { const int c = 16 * sb + l15;
            const int row = type == 0 ? 64 * Gi + c : (type == 1 ? 3072 + (Gi >> 2) * 256 + (c >> 5) * 128 + (Gi & 3) * 32 + (c & 31) : 5120 + 64 * Gi + c);
            arow[sb] = F.WinT + (size_t)row * D + w * 512 + 8 * kq; }
        const bf16* brow = F.HNM + (size_t)l15 * D + w * 512 + 8 * kq;
        f32x4 acc[4];
#pragma unroll
        for (int sb = 0; sb < 4; ++sb) acc[sb] = (f32x4){0.f, 0.f, 0.f, 0.f};
#pragma unroll 4
        for (int ks = 0; ks < 16; ++ks) { const bf16x8 b = *(const bf16x8*)(brow + 32 * ks);
#pragma unroll
            for (int sb = 0; sb < 4; ++sb) { const bf16x8 a = *(const bf16x8*)(arow[sb] + 32 * ks); acc[sb] = __builtin_amdgcn_mfma_f32_16x16x32_bf16(a, b, acc[sb], 0, 0, 0); } }
        LAS f32x4* part = (LAS f32x4*)(F.lds + RING_OFF);
#pragma unroll
        for (int sb = 0; sb < 4; ++sb) part[(w * 4 + sb) * 64 + lane] = acc[sb];
        __syncthreads();
        if (F.tid < 256) {
            const int j = F.tid >> 4, cq = F.tid & 15, l = j + 16 * (cq & 3), sb = cq >> 2;
            f32x4 v = (f32x4){0.f, 0.f, 0.f, 0.f};
#pragma unroll
            for (int w2 = 0; w2 < 8; ++w2) v += part[(w2 * 4 + sb) * 64 + l];
            if (type == 1) { float ss = (v.x * v.x + v.y * v.y) + (v.z * v.z + v.w * v.w);
                ss += __shfl_xor(ss, 1); ss += __shfl_xor(ss, 2); ss += __shfl_xor(ss, 4); ss += __shfl_xor(ss, 8);
                const float r = 1.0f / sqrtf(ss * (1.0f / 64.0f) + EPS); const f32x4 gn = *(const f32x4*)(F.in[I_KG] + 4 * cq); v = v * r * gn; }
            uint2 o; o.x = pk2(v.x, v.y); o.y = pk2(v.z, v.w);
            if (type == 0) *(uint2*)(F.UM + j * D_SSM + 64 * Gi + 4 * cq) = o;
            else { bf16* base = type == 1 ? F.K : F.V;
#pragma unroll
                for (int b = 0; b < BATCH; ++b) *(uint2*)(base + (size_t)(b * KVROWS + 48 + j) * 2048 + 64 * Gi + 4 * cq) = o; }
        }
    } else {
        const int nth = ((int)gridDim.x - 80) * NWAVES * 64;
        for (int i = ((int)blockIdx.x - 80) * NWAVES * 64 + F.tid; i < 2 * BATCH * 48 * 256; i += nth) {
            const int tensor = i / (BATCH * 48 * 256), r = i % (BATCH * 48 * 256), b = r / (48 * 256), rr = (r % (48 * 256)) / 256, ch = r % 256;
            bf16* p = (tensor ? F.V : F.K) + (size_t)(b * KVROWS + rr) * 2048 + ch * 8;
            *(v4u*)p = (v4u){0u, 0u, 0u, 0u};
        }
    }
    __syncthreads();
}

__device__ __forceinline__ float gelu_tanh(float x) { const float z = 0.7978845608028654f * (x + 0.044715f * x * x * x); const float e = __expf(2.0f * z); return 0.5f * x * (2.0f - 2.0f / (e + 1.0f)); }
constexpr int BB_LD = 132;
__device__ __forceinline__ void build_bias_table(Frame& F, LAS float* bbt) {
    const float mq = wave_max(fabsf(F.in[I_QG][F.lane])), mk = wave_max(fabsf(F.in[I_KG][F.lane]));
    const float* rb = F.in[I_RELB];
    for (int idx = F.tid; idx < NH * 129; idx += NWAVES * 64) { const int h = idx / 129, d = idx % 129;
        int bucket = d; if (d >= 16) { bucket = 16 + (int)(logf((float)d * (1.0f / 16.0f)) / 2.0794415416798357f * 16.0f); bucket = bucket > 31 ? 31 : bucket; }
        float mb = rb[h];
#pragma unroll 4
        for (int b = 1; b < 32; ++b) mb = fmaxf(mb, rb[b * NH + h]);
        bbt[h * BB_LD + d] = (rb[bucket * NH + h] - (8.0f * mq * mk + mb)) * LOG2E; }
}
__device__ __forceinline__ float diff_lambda(Frame& F) {
    const float s1 = wave_sum(F.in[I_LQ1][F.lane] * F.in[I_LK1][F.lane]), s2 = wave_sum(F.in[I_LQ2][F.lane] * F.in[I_LK2][F.lane]);
    return expf(s1) - expf(s2) + LAMBDA_INIT;
}
__device__ __forceinline__ void attn_naive(Frame& F) {
    LAS float* bbt = (LAS float*)(F.lds + RING_OFF);
    LAS float* qs = (LAS float*)(F.lds + RING_OFF + 16384) + F.wave * 128;
    build_bias_table(F, bbt);
    __syncthreads();
    const float lam = diff_lambda(F);
    const int lane = F.lane, gw = F.vcu * NWAVES + F.wave, NGW = F.G * NWAVES;
    const float sg0 = F.in[I_SUBG][2 * lane], sg1 = F.in[I_SUBG][2 * lane + 1];
    for (int qq = gw; qq < SEQ / 2; qq += NGW)
        for (int it = 0; it < 2 * BATCH * NH; ++it) {
            const int bh = it >> 1, b = bh >> 4, h = bh & 15, q = (it & 1) ? SEQ - 1 - qq : qq;
            bf16* Qrow = F.Q + (size_t)(b * SEQ + q) * QKW + h * 128;
            { const unsigned qw = *(const unsigned*)(Qrow + 2 * lane); qs[2 * lane] = bf_lo(qw); qs[2 * lane + 1] = bf_hi(qw); }
            LDS_WAIT(); asm volatile("" ::: "memory");
            const bf16* Kb = F.K + (size_t)(b * KVROWS) * QKW + h * 128; const bf16* Vb = F.V + (size_t)(b * KVROWS) * DATT + h * 128;
            float o1a = 0.f, o1b = 0.f, o2a = 0.f, o2b = 0.f, l1 = 0.f, l2 = 0.f;
            const int nkeys = q + 65;
            for (int kb = 0; kb * 64 < nkeys; ++kb) {
                const int R = kb * 64 + lane, pos = R - 64; const bool valid = (pos >= -NMETA) && (pos <= q);
                const int Rc = R < KVROWS ? R : KVROWS - 1;
                const v4u* kr = (const v4u*)(Kb + (size_t)Rc * QKW);
                float d1 = 0.f, d2 = 0.f;
#pragma unroll
                for (int c = 0; c < 8; ++c) { const v4u w = kr[c];
                    d1 += qs[8 * c + 0] * bf_lo(w.x) + qs[8 * c + 1] * bf_hi(w.x) + qs[8 * c + 2] * bf_lo(w.y) + qs[8 * c + 3] * bf_hi(w.y) + qs[8 * c + 4] * bf_lo(w.z) + qs[8 * c + 5] * bf_hi(w.z) + qs[8 * c + 6] * bf_lo(w.w) + qs[8 * c + 7] * bf_hi(w.w); }
#pragma unroll
                for (int c = 8; c < 16; ++c) { const v4u w = kr[c];
                    d2 += qs[8 * c + 0] * bf_lo(w.x) + qs[8 * c + 1] * bf_hi(w.x) + qs[8 * c + 2] * bf_lo(w.y) + qs[8 * c + 3] * bf_hi(w.y) + qs[8 * c + 4] * bf_lo(w.z) + qs[8 * c + 5] * bf_hi(w.z) + qs[8 * c + 6] * bf_lo(w.w) + qs[8 * c + 7] * bf_hi(w.w); }
                int dd = q - pos; dd = dd > 128 ? 128 : dd; dd = valid ? dd : 128;
                const float bbv = bbt[h * BB_LD + dd];
                const float p1 = valid ? exp2f(d1 + bbv) : 0.f, p2 = valid ? exp2f(d2 + bbv) : 0.f;
                l1 += p1; l2 += p2;
                const int rem = nkeys - kb * 64, kend = rem < 64 ? rem : 64;
                const bf16* vp = Vb + (size_t)(kb * 64) * DATT + 2 * lane;
                for (int kk = 0; kk < kend; ++kk) { const float a1 = __shfl(p1, kk), a2 = __shfl(p2, kk); const unsigned vw = *(const unsigned*)(vp + (size_t)kk * DATT);
                    const float va = bf_lo(vw), vb = bf_hi(vw); o1a += a1 * va; o1b += a1 * vb; o2a += a2 * va; o2b += a2 * vb; }
            }
            l1 = wave_sum(l1); l2 = wave_sum(l2);
            const float oa = o1a / l1 - lam * o2a / l2, ob = o1b / l1 - lam * o2b / l2;
            const float r = (1.0f - LAMBDA_INIT) / sqrtf(wave_sum(oa * oa + ob * ob) * (1.0f / VD) + EPS);
            *(unsigned*)(Qrow + 2 * lane) = pk2(oa * r * sg0, ob * r * sg1);
        }
}
__device__ __forceinline__ void ssm_naive(Frame& F) {
    if (F.wave != 0) return;
    const int lane = F.lane;
    for (int pair = blockIdx.x; pair < BATCH * NGRP; pair += gridDim.x) {
        const int b = pair >> 6, g = pair & 63, p = lane;
        const double lre = F.in[I_LRE][g * 64 + p], lim = F.in[I_LIM][g * 64 + p], dt = exp((double)F.in[I_LOGDT][g]);
        const double er = exp(lre * dt), ar = er * cos(lim * dt), ai = er * sin(lim * dt);
        const double nr = ar - 1.0, ni = ai, den = lre * lre + lim * lim, fr = (nr * lre + ni * lim) / den, fi = (ni * lre - nr * lim) / den;
        float bbr[16], bbi[16], cr[16], ci[16];
#pragma unroll
        for (int c = 0; c < 16; ++c) { const double br = F.in[I_BRE][(g * 64 + p) * 16 + c], bi = F.in[I_BIM][(g * 64 + p) * 16 + c];
            bbr[c] = (float)(fr * br - fi * bi); bbi[c] = (float)(fr * bi + fi * br);
            cr[c] = F.in[I_CRE][(g * 16 + c) * 64 + p]; ci[c] = F.in[I_CIM][(g * 16 + c) * 64 + p]; }
        const float a_r = (float)ar, a_i = (float)ai;
        const float dsk = F.in[I_DSKIP][g * 16 + (lane & 15)];
        float sr = 0.f, si = 0.f;
        const int T = SEQ + NMETA;
#define U_PTR(t) ((t) < NMETA ? (const v4u*)(F.UM + (t) * D_SSM + g * 16) : (const v4u*)(F.U + (size_t)(b * SEQ + (t) - NMETA) * D_SSM + g * 16))
        v4u c0 = U_PTR(0)[0], c1 = U_PTR(0)[1], n0 = U_PTR(1)[0], n1 = U_PTR(1)[1];
        for (int t = 0; t < T; ++t) {
            const int t2 = t + 2 < T ? t + 2 : T - 1;
            const v4u m0 = U_PTR(t2)[0], m1 = U_PTR(t2)[1];
            float u[16];
            u[0] = bf_lo(c0.x); u[1] = bf_hi(c0.x); u[2] = bf_lo(c0.y); u[3] = bf_hi(c0.y); u[4] = bf_lo(c0.z); u[5] = bf_hi(c0.z); u[6] = bf_lo(c0.w); u[7] = bf_hi(c0.w);
            u[8] = bf_lo(c1.x); u[9] = bf_hi(c1.x); u[10] = bf_lo(c1.y); u[11] = bf_hi(c1.y); u[12] = bf_lo(c1.z); u[13] = bf_hi(c1.z); u[14] = bf_lo(c1.w); u[15] = bf_hi(c1.w);
            float br_ = 0.f, bi_ = 0.f;
#pragma unroll
            for (int c = 0; c < 16; ++c) { br_ += bbr[c] * u[c]; bi_ += bbi[c] * u[c]; }
            const float nsr = a_r * sr - a_i * si + br_, nsi = a_r * si + a_i * sr + bi_; sr = nsr; si = nsi;
            float ymine = 0.f;
#pragma unroll
            for (int c = 0; c < 16; ++c) { const float v = wave_sum(cr[c] * sr - ci[c] * si); if (lane == c) ymine = v + dsk * u[c]; }
            if (t >= NMETA && lane < 16) F.Gb[(size_t)(b * SEQ + t - NMETA) * D_SSM + g * 16 + lane] = (bf16)f2bf(gelu_tanh(ymine));
            c0 = n0; c1 = n1; n0 = m0; n1 = m1;
        }
#undef U_PTR
    }
}
struct Args { const float* in[27]; float* out; unsigned char* ws; int ph_lo, ph_hi, li, pad; };
__global__ void __launch_bounds__(NWAVES * 64, 2) mk_fwd(Args args) {
    extern __shared__ __attribute__((aligned(16))) unsigned char lds[];
    Frame F;
    F.lds = (LAS unsigned char*)lds;
    F.MISC = (volatile LAS unsigned*)(F.lds + MISC_OFF);
    F.tid = threadIdx.x; F.lane = F.tid & 63; F.wave = __builtin_amdgcn_readfirstlane(F.tid >> 6);
    F.G = gridDim.x; { const int bx = blockIdx.x; F.vcu = (F.G % 8 == 0) ? (bx % 8) * (F.G / 8) + bx / 8 : bx; }
    unsigned char* ws = args.ws; F.ws = ws; F.out = args.out;
#pragma unroll
    for (int i = 0; i < 27; ++i) F.in[i] = args.in[i];
    F.ctl = (gu32*)(ws + WS_CTL);
    F.WinT = (bf16*)(ws + WS_WIN); F.WgluT = (bf16*)(ws + WS_WGLU); F.WbraT = (bf16*)(ws + WS_WBRA); F.WbrbT = (bf16*)(ws + WS_WBRB); F.WoT = (bf16*)(ws + WS_WO); F.WguT = (bf16*)(ws + WS_WGU); F.WdnT = (bf16*)(ws + WS_WDN);
    F.HN = (bf16*)(ws + WS_HN); F.TM = (bf16*)(ws + WS_TM); F.U = (bf16*)(ws + WS_U); F.Q = (bf16*)(ws + WS_Q); F.K = (bf16*)(ws + WS_K); F.V = (bf16*)(ws + WS_V); F.GS = (bf16*)(ws + WS_GS); F.GA = (bf16*)(ws + WS_GA);
    F.ACT = (bf16*)(ws + WS_ACT); F.Gb = (bf16*)(ws + WS_G); F.YSSM = (bf16*)(ws + WS_YSSM); F.HNM = (bf16*)(ws + WS_HNM); F.UM = (bf16*)(ws + WS_UM); F.PS = (float*)(ws + WS_PS);
    for (int u = F.tid; u < (LDS_BYTES - LDSCTL_OFF) / 4; u += NWAVES * 64) ((LAS unsigned*)(F.lds + LDSCTL_OFF))[u] = 0u;
    __syncthreads();
    XcdBarrier bar; bar.bar = (unsigned*)(F.ctl + CW_BAR); bar.x = 0; bar.st = nullptr;
    if (N_LAUNCHES == 1) bar = xcd_barrier_post((unsigned*)(F.ctl + CW_BAR), F.MISC + 8);
#define GRID_BAR(seam) do { if (N_LAUNCHES != 1) { if (F.tid == 0) __hip_atomic_store(F.ctl + CW_TMO, 0xBADBA0u | (unsigned)(seam), RLX_AGENT); } else { xcd_barrier(bar); } } while (0)
    const int lo = args.ph_lo, hi = args.ph_hi;
#define IN(k) (lo <= (k) && (k) < hi)
#define BOTH(k) (IN(k) && IN((k) + 1))
    using namespace pg8;
    if (IN(0)) { p0_prologue(F); if (BOTH(0)) GRID_BAR(0); }
    if (IN(1)) {
        meta_proj(F);
        Gemm g{F.HN, F.WinT, M, D_IN, D}; StaticOrder S; S.init(M, D_IN, F.G, (int)blockIdx.x);
        EpiInProj E{F.U, F.Q, F.K, F.V, F.GS, F.GA, F.in[I_QG], F.in[I_KG]};
        gemm_phase<EpiInProj, StaticOrder, PG8_ALIGN, PG8_SP2>(F.lds + RING_OFF, g, S, E);
        if (BOTH(1)) GRID_BAR(1);
    }
    if (IN(2)) {
        attn_naive(F);
        ssm_naive(F);
        if (BOTH(2)) GRID_BAR(2);
    }
    if (IN(3)) {
        { Gemm g{F.Gb, F.WgluT, M, D_SSM, D_SSM}; StaticOrder S; S.init(M, D_SSM, F.G, (int)blockIdx.x);
          EpiGlu E{F.Gb, F.in[I_BGLU], F.YSSM};
          gemm_phase<EpiGlu, StaticOrder, PG8_ALIGN, PG8_SP2>(F.lds + RING_OFF, g, S, E); }
        { Gemm g{F.Q, F.WbrbT, M, D, DATT}; StaticOrder S; S.init(M, D, F.G, (int)blockIdx.x);
          EpiBranch<true> E{F.GA, F.TM};
          gemm_phase<EpiBranch<true>, StaticOrder, PG8_ALIGN, PG8_SP2>(F.lds + RING_OFF, g, S, E); }
        if (BOTH(3)) GRID_BAR(3);
    }
    if (IN(4)) {
        Gemm g{F.YSSM, F.WbraT, M, D, D_SSM}; StaticOrder S; S.init(M, D, F.G, (int)blockIdx.x);
        EpiBranch<false> E{F.GS, F.TM};
        gemm_phase<EpiBranch<false>, StaticOrder, PG8_ALIGN, PG8_SP2>(F.lds + RING_OFF, g, S, E);
        if (BOTH(4)) GRID_BAR(4);
    }
    if (IN(5)) {
        Gemm g{F.TM, F.WoT, M, D, D}; StaticOrder S; S.init(M, D, F.G, (int)blockIdx.x);
        EpiOut E{F.in[I_X], F.out, F.HN, F.PS};
        gemm_phase<EpiOut, StaticOrder, PG8_ALIGN, PG8_SP2>(F.lds + RING_OFF, g, S, E);
        if (BOTH(5)) GRID_BAR(5);
    }
    if (IN(6)) {
        Gemm g{F.HN, F.WguT, M, 2 * D_FF, D}; StaticOrder S; S.init(M, 2 * D_FF, F.G, (int)blockIdx.x);
        EpiGateUp E{F.PS, F.ACT};
        gemm_phase<EpiGateUp, StaticOrder, PG8_ALIGN, PG8_SP2>(F.lds + RING_OFF, g, S, E);
        if (BOTH(6)) GRID_BAR(6);
    }
    if (IN(7)) {
        Gemm g{F.ACT, F.WdnT, M, D, D_FF}; StaticOrder S; S.init(M, D, F.G, (int)blockIdx.x);
        EpiDown E{F.out};
        gemm_phase<EpiDown, StaticOrder, PG8_ALIGN, PG8_SP2>(F.lds + RING_OFF, g, S, E);
    }
#undef IN
#undef BOTH
}

extern "C" void kernel_launch(void* const* d_in, const int* in_sizes, int n_in, void* d_out, int out_size, void* d_ws, size_t ws_size, hipStream_t stream) {
    static int grid = 0;
    if (grid == 0) {
        if (n_in != 27 || in_sizes[0] != M * D || out_size != M * D || ws_size < WS_END) { fprintf(stderr, "kernel_launch: built for 27 inputs, x and out of %d floats, >= %zu bytes of workspace; got n_in %d, in0 %d, out %d, ws %zu; nothing launched\n", M * D, (size_t)WS_END, n_in, n_in > 0 ? in_sizes[0] : -1, out_size, ws_size); grid = -1; return; }
        int dev = 0, cus = 0, per_cu = 0;
        if (hipGetDevice(&dev) != hipSuccess || hipDeviceGetAttribute(&cus, hipDeviceAttributeMultiprocessorCount, dev) != hipSuccess) { fprintf(stderr, "kernel_launch: hipGetDevice / hipDeviceGetAttribute failed; nothing launched\n"); grid = -1; return; }
        if (hipFuncSetAttribute((const void*)mk_fwd, hipFuncAttributeMaxDynamicSharedMemorySize, LDS_BYTES) != hipSuccess) { fprintf(stderr, "kernel_launch: hipFuncSetAttribute failed; nothing launched\n"); grid = -1; return; }
        if (hipOccupancyMaxActiveBlocksPerMultiprocessor(&per_cu, (const void*)mk_fwd, NWAVES * 64, LDS_BYTES) != hipSuccess || per_cu < 1)
            fprintf(stderr, "kernel_launch: note: the occupancy query reports %d workgroups per CU\n", per_cu);
        (void)hipGetLastError();
        grid = cus;
    }
    if (grid < 0) return;
    if (hipMemsetAsync((char*)d_ws + WS_CTL, 0, CTL_ZERO_BYTES, stream) != hipSuccess) { fprintf(stderr, "kernel_launch: hipMemsetAsync of the control words failed; nothing launched\n"); return; }
    Args a{};
    for (int i = 0; i < 27; ++i) a.in[i] = (const float*)d_in[i];
    a.out = (float*)d_out; a.ws = (unsigned char*)d_ws;
    for (int li = 0; li < N_LAUNCHES; ++li) {
        a.ph_lo = (N_LAUNCHES == 1) ? 0 : li; a.ph_hi = (N_LAUNCHES == 1) ? N_PHASES : li + 1; a.li = li;
        hipLaunchKernelGGL(mk_fwd, dim3(grid), dim3(NWAVES * 64), LDS_BYTES, stream, a);
        const hipError_t le = hipPeekAtLastError();
        if (le != hipSuccess) { fprintf(stderr, "kernel_launch: launch %d failed: %s (grid %d x %d threads, %d B LDS)\n", li, hipGetErrorName(le), grid, NWAVES * 64, LDS_BYTES); break; }
    }
}
```

```cpp
#include <hip/hip_runtime.h>
#include <hip/hip_bf16.h>
#include <cstdio>
#include <cstdint>
#include <cmath>
namespace pg8 {
#define PG8_LAS __attribute__((address_space(3)))
typedef unsigned short bf16_t;
typedef short bf16x8 __attribute__((ext_vector_type(8)));
typedef float f32x4 __attribute__((ext_vector_type(4)));
typedef unsigned u32x4 __attribute__((ext_vector_type(4)));
constexpr int BM = 256, BK = 64, HALF = 128, HTB = HALF * BK * 2  , STAGE_BYTES = 8 * HTB, NXCD = 8, WGM = 8;

__host__ __device__ __forceinline__ int lds_byte(int r, int c) { const int st = (r >> 4) * 2 + (c >> 5), rr = r & 15, cc = c & 31, ob = rr * 64 + cc * 2; return st * 1024 + (ob ^ (((ob >> 9) & 1) << 5)); }
__host__ __device__ __forceinline__ void stage_rc(int b, int& R, int& C) { const int st = b / 1024, sb = b % 1024, swz = sb ^ (((sb >> 9) & 1) << 5); R = (st >> 1) * 16 + swz / 64; C = (st & 1) * 32 + (swz % 64) / 2; }
__host__ __device__ __forceinline__ int perm32(int rho) { const int n = rho >> 4, i = rho & 15; return 8 * (i >> 2) + 4 * n + (i & 3); }

struct Unit { int pm, pn; };
struct Gemm { const bf16_t* A; const bf16_t* Bt; int M, N, K; };

struct StaticOrder {
    int nM, nN, nwg, G, c;
    __host__ __device__ void init(int M, int N, int G_, int c_) { nM = M / BM; nN = N / BM; nwg = nM * nN; G = G_; c = c_; }
    __host__ __device__ bool next(int i, Unit& u) const {
        const long L = (long)i * G + c; if (L >= nwg) return false;
        int wgid = (int)L; { const int q = nwg / NXCD, r = nwg % NXCD, xcd = wgid % NXCD, off = wgid / NXCD; wgid = (xcd < r ? xcd * (q + 1) : r * (q + 1) + (xcd - r) * q) + off; }
        const int nig = WGM * nN, gid = wgid / nig, fm = gid * WGM, gsz = (nM - fm) < WGM ? (nM - fm) : WGM;
        u.pm = fm + ((wgid % nig) % gsz); u.pn = (wgid % nig) / gsz; return true;
    }
    __device__ __forceinline__ void a_ready(const Unit&) const {}
    __device__ __forceinline__ void done(const Unit&) const {}
};
struct ARowOnceOrder {
    int G, c;
    __host__ __device__ void init(int, int, int G_, int c_) { G = G_; c = c_; }
    __host__ __device__ bool next(int i, Unit& u) const {
        if (G != 256 || i >= 4) { if (G == 256) return false; const long L = (long)i * G + c; if (L >= 64 * 16) return false; u.pm = (int)(L >> 4); u.pn = (int)(L & 15); return true; }
        const int x = c & 7, j = c >> 3;
        u.pm = 16 * i + 4 * (x >> 1) + (j >> 3); u.pn = 8 * (x & 1) + (j & 7); return true;
    }
    __device__ __forceinline__ void a_ready(const Unit&) const {}
    __device__ __forceinline__ void done(const Unit&) const {}
};
struct TailOrder : StaticOrder {
    unsigned* q; volatile PG8_LAS unsigned* slot; int tail;
    __device__ __forceinline__ bool next(int i, Unit& u) const {
        if (i < tail) return StaticOrder::next(i, u);
        if (i > tail) return false;
        if (threadIdx.x == 0) { const unsigned k = __hip_atomic_fetch_add(q, 1u, __ATOMIC_RELAXED, __HIP_MEMORY_SCOPE_AGENT); *slot = k; }
        asm volatile("s_waitcnt lgkmcnt(0)" ::: "memory"); __builtin_amdgcn_s_barrier(); asm volatile("" ::: "memory");
        const long L = (long)tail * G + (long)*slot; if (L >= nwg) return false;
        int wgid = (int)L; { const int qq = nwg / NXCD, r = nwg % NXCD, xcd = wgid % NXCD, off = wgid / NXCD; wgid = (xcd < r ? xcd * (qq + 1) : r * (qq + 1) + (xcd - r) * qq) + off; }
        const int nig = WGM * nN, gid = wgid / nig, fm = gid * WGM, gsz = (nM - fm) < WGM ? (nM - fm) : WGM;
        u.pm = fm + ((wgid % nig) % gsz); u.pn = (wgid % nig) / gsz; return true;
    }
};

__device__ __forceinline__ unsigned cvt_pk_bf16(float lo, float hi) { unsigned r; asm volatile("v_cvt_pk_bf16_f32 %0, %1, %2" : "=v"(r) : "v"(lo), "v"(hi)); return r; }
typedef float f32x2 __attribute__((ext_vector_type(2)));
constexpr float kEps = 1e-6f;
constexpr float kQScale = 0.125f * 1.4426950408889634f;
__device__ __forceinline__ float sigm(float x) { return __builtin_amdgcn_rcpf(1.0f + __builtin_amdgcn_exp2f(-1.4426950408889634f * x)); }
__device__ __forceinline__ void unpack8(const u32x4 w, float (&f)[8]) {
    f[0] = __uint_as_float(w.x << 16); f[1] = __uint_as_float(w.x & 0xffff0000u); f[2] = __uint_as_float(w.y << 16); f[3] = __uint_as_float(w.y & 0xffff0000u);
    f[4] = __uint_as_float(w.z << 16); f[5] = __uint_as_float(w.z & 0xffff0000u); f[6] = __uint_as_float(w.w << 16); f[7] = __uint_as_float(w.w & 0xffff0000u);
}
__device__ __forceinline__ u32x4 pack8(const f32x4 a, const f32x4 b) { u32x4 w; w.x = cvt_pk_bf16(a[0], a[1]); w.y = cvt_pk_bf16(a[2], a[3]); w.z = cvt_pk_bf16(b[0], b[1]); w.w = cvt_pk_bf16(b[2], b[3]); return w; }
#define EPI_FENCE() asm volatile("" ::: "memory")

struct EpiInProj {
    static constexpr bool PERM = true, AFTER_DRAIN = false;
    bf16_t *U, *Q, *K, *V, *GS, *GA; const float *qg, *kg;
    __device__ __forceinline__ void operator()(const f32x4 (&acc)[2][2][4][2], const Unit& u, int wr, int wc, int fr, int fq) const {
        const int pn = u.pn; const int row0 = u.pm * BM + wr * 64 + fr;
        const int kvoff = 64 * (u.pm / 16 + 1);
        if (pn >= 4 && pn < 20) {
            const bool isq = pn < 12; const int tile = isq ? pn - 4 : pn - 12;
            bf16_t* base = isq ? Q : K; const float* g = isq ? qg : kg; const float sc = isq ? kQScale : 1.0f; const int roff = isq ? 0 : kvoff;
            f32x4 gv[2][2];
#pragma unroll
            for (int bj = 0; bj < 2; ++bj)
#pragma unroll
                for (int n = 0; n < 2; ++n) gv[bj][n] = *(const f32x4*)(g + 32 * bj + 8 * fq + 4 * n) * sc;
#pragma unroll
            for (int ai = 0; ai < 2; ++ai)
#pragma unroll
                for (int m = 0; m < 4; ++m) {
                    float ss = 0.f;
#pragma unroll
                    for (int bj = 0; bj < 2; ++bj)
#pragma unroll
                        for (int n = 0; n < 2; ++n) { const f32x4 x = acc[ai][bj][m][n]; ss += (x[0] * x[0] + x[1] * x[1]) + (x[2] * x[2] + x[3] * x[3]); }
                    ss += __shfl_xor(ss, 16); ss += __shfl_xor(ss, 32);
                    const float rstd = __builtin_amdgcn_rsqf(ss * (1.0f / 64.0f) + kEps);
                    bf16_t* rowp = base + (size_t)(row0 + ai * HALF + m * 16 + roff) * 2048 + tile * 256 + 64 * wc + 8 * fq;
#pragma unroll
                    for (int bj = 0; bj < 2; ++bj) *(u32x4*)(rowp + 32 * bj) = pack8(acc[ai][bj][m][0] * rstd * gv[bj][0], acc[ai][bj][m][1] * rstd * gv[bj][1]);
                }
            return;
        }
        bf16_t* base; int ldc, colt, roff = 0; bool sg = false;
        if (pn < 4) { base = U; ldc = 1024; colt = pn * BM; }
        else if (pn < 28) { base = V; ldc = 2048; colt = (pn - 20) * BM; roff = kvoff; }
        else if (pn < 44) { base = GS; ldc = 4096; colt = (pn - 28) * BM; sg = true; }
        else { base = GA; ldc = 4096; colt = (pn - 44) * BM; sg = true; }
        const int col0 = colt + wc * 32 + 8 * fq;
#pragma unroll
        for (int ai = 0; ai < 2; ++ai)
#pragma unroll
            for (int m = 0; m < 4; ++m) { bf16_t* rowp = base + (size_t)(row0 + ai * HALF + m * 16 + roff) * ldc + col0;
#pragma unroll
                for (int bj = 0; bj < 2; ++bj) { f32x4 v0 = acc[ai][bj][m][0], v1 = acc[ai][bj][m][1];
                    if (sg) {
#pragma unroll
                        for (int e = 0; e < 4; ++e) { v0[e] = sigm(v0[e]); v1[e] = sigm(v1[e]); } }
                    *(u32x4*)(rowp + bj * HALF) = pack8(v0, v1); } }
    }
};
struct EpiGlu {
    static constexpr bool PERM = true, AFTER_DRAIN = false;
    const bf16_t* G; const float* bias; bf16_t* Y;
    __device__ __forceinline__ void operator()(const f32x4 (&acc)[2][2][4][2], const Unit& u, int wr, int wc, int fr, int fq) const {
        const int row0 = u.pm * BM + wr * 64 + fr, col0 = u.pn * BM + wc * 32 + 8 * fq;
        f32x4 bv[2][2];
#pragma unroll
        for (int bj = 0; bj < 2; ++bj)
#pragma unroll
            for (int n = 0; n < 2; ++n) bv[bj][n] = *(const f32x4*)(bias + col0 + bj * HALF + 4 * n);
#pragma unroll
        for (int ai = 0; ai < 2; ++ai)
#pragma unroll
            for (int m = 0; m < 4; ++m) { const size_t off = (size_t)(row0 + ai * HALF + m * 16) * 1024 + col0;
#pragma unroll
                for (int bj = 0; bj < 2; ++bj) { float g[8]; unpack8(*(const u32x4*)(G + off + bj * HALF), g);
                    f32x4 v0 = acc[ai][bj][m][0] + bv[bj][0], v1 = acc[ai][bj][m][1] + bv[bj][1];
#pragma unroll
                    for (int e = 0; e < 4; ++e) { v0[e] = g[e] * sigm(v0[e]); v1[e] = g[4 + e] * sigm(v1[e]); }
                    *(u32x4*)(Y + off + bj * HALF) = pack8(v0, v1); }
                EPI_FENCE(); }
    }
};
template <bool FIRST> struct EpiBranch {
    static constexpr bool PERM = true, AFTER_DRAIN = false;
    const bf16_t* GATE; bf16_t* T;
    __device__ __forceinline__ void operator()(const f32x4 (&acc)[2][2][4][2], const Unit& u, int wr, int wc, int fr, int fq) const {
        const int row0 = u.pm * BM + wr * 64 + fr, col0 = u.pn * BM + wc * 32 + 8 * fq;
#pragma unroll
        for (int ai = 0; ai < 2; ++ai)
#pragma unroll
            for (int m = 0; m < 4; ++m) { const size_t off = (size_t)(row0 + ai * HALF + m * 16) * 4096 + col0;
#pragma unroll
                for (int bj = 0; bj < 2; ++bj) { float g[8]; unpack8(*(const u32x4*)(GATE + off + bj * HALF), g);
                    f32x4 v0 = acc[ai][bj][m][0], v1 = acc[ai][bj][m][1];
                    if (FIRST) {
#pragma unroll
                        for (int e = 0; e < 4; ++e) { v0[e] *= g[e]; v1[e] *= g[4 + e]; }
                    } else { float t[8]; unpack8(*(const u32x4*)(T + off + bj * HALF), t);
#pragma unroll
                        for (int e = 0; e < 4; ++e) { v0[e] = t[e] + v0[e] * g[e]; v1[e] = t[4 + e] + v1[e] * g[4 + e]; } }
                    *(u32x4*)(T + off + bj * HALF) = pack8(v0, v1); }
                EPI_FENCE(); }
    }
};
struct EpiOut {
    static constexpr bool PERM = true, AFTER_DRAIN = false;
    const float* X; bf16_t* HB; float* PS;
    __device__ __forceinline__ void operator()(const f32x4 (&acc)[2][2][4][2], const Unit& u, int wr, int wc, int fr, int fq) const {
        const int row0 = u.pm * BM + wr * 64 + fr, col0 = u.pn * BM + wc * 32 + 8 * fq;
#pragma unroll
        for (int ai = 0; ai < 2; ++ai)
#pragma unroll
            for (int m = 0; m < 4; ++m) { const int row = row0 + ai * HALF + m * 16; const size_t off = (size_t)row * 4096 + col0; float ss = 0.f;
#pragma unroll
                for (int bj = 0; bj < 2; ++bj) { const f32x4 x0 = *(const f32x4*)(X + off + bj * HALF), x1 = *(const f32x4*)(X + off + bj * HALF + 4);
                    const f32x4 v0 = acc[ai][bj][m][0] + x0, v1 = acc[ai][bj][m][1] + x1;
                    ss += (v0[0] * v0[0] + v0[1] * v0[1]) + (v0[2] * v0[2] + v0[3] * v0[3]) + (v1[0] * v1[0] + v1[1] * v1[1]) + (v1[2] * v1[2] + v1[3] * v1[3]);
                    *(u32x4*)(HB + off + bj * HALF) = pack8(v0, v1); }
                ss += __shfl_xor(ss, 16); ss += __shfl_xor(ss, 32);
                if (fq == 0) PS[(size_t)row * 64 + u.pn * 4 + wc] = ss;
                EPI_FENCE(); }
    }
};
struct EpiGateUp {
    static constexpr bool PERM = true, AFTER_DRAIN = false;
    const float* PS; bf16_t* ACT;
    __device__ __forceinline__ void operator()(const f32x4 (&acc)[2][2][4][2], const Unit& u, int wr, int wc, int fr, int fq) const {
        const int row0 = u.pm * BM + wr * 64 + fr, col0 = u.pn * HALF + wc * 32 + 8 * fq;
#pragma unroll
        for (int ai = 0; ai < 2; ++ai)
#pragma unroll
            for (int m = 0; m < 4; ++m) { const int row = row0 + ai * HALF + m * 16;
                const f32x4* ps = (const f32x4*)(PS + (size_t)row * 64 + fq * 16);
                const f32x4 p0 = ps[0], p1 = ps[1], p2 = ps[2], p3 = ps[3];
                float ss = ((p0[0] + p0[1]) + (p0[2] + p0[3])) + ((p1[0] + p1[1]) + (p1[2] + p1[3])) + ((p2[0] + p2[1]) + (p2[2] + p2[3])) + ((p3[0] + p3[1]) + (p3[2] + p3[3]));
                ss += __shfl_xor(ss, 16); ss += __shfl_xor(ss, 32);
                const float r = __builtin_amdgcn_rsqf(ss * (1.0f / 4096.0f) + kEps);
                f32x4 v0, v1;
#pragma unroll
                for (int e = 0; e < 4; ++e) { const float g0 = acc[ai][0][m][0][e] * r, u0 = acc[ai][1][m][0][e] * r, g1 = acc[ai][0][m][1][e] * r, u1 = acc[ai][1][m][1][e] * r;
                    v0[e] = g0 * sigm(g0) * u0; v1[e] = g1 * sigm(g1) * u1; }
                *(u32x4*)(ACT + (size_t)row * 11008 + col0) = pack8(v0, v1);
                EPI_FENCE(); }
    }
};
struct EpiDown {
    static constexpr bool PERM = true, AFTER_DRAIN = false;
    const bf16_t* HB; float* OUT;
    __device__ __forceinline__ void operator()(const f32x4 (&acc)[2][2][4][2], const Unit& u, int wr, int wc, int fr, int fq) const {
        const int row0 = u.pm * BM + wr * 64 + fr, col0 = u.pn * BM + wc * 32 + 8 * fq;
#pragma unroll
        for (int ai = 0; ai < 2; ++ai)
#pragma unroll
            for (int m = 0; m < 4; ++m) { const size_t off = (size_t)(row0 + ai * HALF + m * 16) * 4096 + col0;
#pragma unroll
                for (int bj = 0; bj < 2; ++bj) { float h[8]; unpack8(*(const u32x4*)(HB + off + bj * HALF), h); f32x4* p = (f32x4*)(OUT + off + bj * HALF);
                    p[0] = acc[ai][bj][m][0] + (f32x4){h[0], h[1], h[2], h[3]}; p[1] = acc[ai][bj][m][1] + (f32x4){h[4], h[5], h[6], h[7]}; }
                EPI_FENCE(); }
    }
};
template <class Epi, class Sched, bool ALIGN_EPI = false, bool SP2 = false, bool PLOCAL = false>
__device__ __forceinline__ void gemm_phase(PG8_LAS unsigned char* lds, const Gemm g, const Sched& S, const Epi& E) {
    const int tid = threadIdx.x, wid = __builtin_amdgcn_readfirstlane(tid >> 6), lane = tid & 63, wr = wid >> 2, wc = wid & 3, fr = lane & 15, fq = lane >> 4;
    const int K = g.K, nt = K / BK;
    unsigned voffA[2], voffB[2];
#pragma unroll
    for (int i = 0; i < 2; ++i) { int R, C; stage_rc(tid * 16 + i * 8192, R, C); const int Rb = Epi::PERM ? ((R & ~31) + perm32(R & 31)) : R;
        voffA[i] = (unsigned)(R * K + C) * 2u; voffB[i] = (unsigned)(Rb * K + C) * 2u; }
    const size_t kstep = (size_t)(BK * 2);
    const size_t hstep = (size_t)HALF * K * 2;
    const size_t tstep = 2 * hstep;
    const unsigned ldsw = (unsigned)wid * 1024u;
    const int aoff = lds_byte(wr * 64 + fr, fq * 8), boff = lds_byte(wc * 32 + fr, fq * 8);
#define PG8_SA(b, h) (((b) * 2 + (h)) * HTB)
#define PG8_SB(b, h) ((4 + (b) * 2 + (h)) * HTB)
#define PG8_STAGE(bufoff, gbase, voff) do { _Pragma("unroll") for (int _i = 0; _i < 2; ++_i) \
        __builtin_amdgcn_global_load_lds((const unsigned*)((const char*)(gbase) + (voff)[_i]), (PG8_LAS unsigned*)(lds + (bufoff) + ldsw + _i * 8192), 16, 0, 0); } while (0)
#define PG8_LDA(dst, b, h) do { _Pragma("unroll") for (int m = 0; m < 4; ++m) _Pragma("unroll") for (int k = 0; k < 2; ++k) dst[m][k] = *(const PG8_LAS bf16x8*)(lds + PG8_SA(b, h) + aoff + m * 2048 + k * 1024); } while (0)
#define PG8_LDB(dst, b, h) do { _Pragma("unroll") for (int n = 0; n < 2; ++n) _Pragma("unroll") for (int k = 0; k < 2; ++k) dst[n][k] = *(const PG8_LAS bf16x8*)(lds + PG8_SB(b, h) + boff + n * 2048 + k * 1024); } while (0)
#define PG8_MMA(ai, bj, At, Bt) do { __builtin_amdgcn_s_setprio(1); _Pragma("unroll") for (int m = 0; m < 4; ++m) _Pragma("unroll") for (int n = 0; n < 2; ++n) _Pragma("unroll") for (int k = 0; k < 2; ++k) \
        acc[ai][bj][m][n] = __builtin_amdgcn_mfma_f32_16x16x32_bf16(Bt[n][k], At[m][k], acc[ai][bj][m][n], 0, 0, 0); __builtin_amdgcn_s_setprio(0); } while (0)
#define PG8_WAIT_V(n) asm volatile("s_waitcnt vmcnt(" #n ")" ::: "memory")
#define PG8_WAIT_L(n) asm volatile("s_waitcnt lgkmcnt(" #n ")" ::: "memory")
#define PG8_BAR __builtin_amdgcn_s_barrier()
#define PG8_SCHED __builtin_amdgcn_sched_barrier(0)
    Unit cur, nxt; int ui = 0;
    if (!S.next(0, cur)) return;
    f32x4 acc[2][2][4][2];
#pragma unroll
    for (int a = 0; a < 2; ++a)
#pragma unroll
        for (int b = 0; b < 2; ++b)
#pragma unroll
            for (int m = 0; m < 4; ++m)
#pragma unroll
                for (int n = 0; n < 2; ++n) acc[a][b][m][n] = (f32x4){0.f, 0.f, 0.f, 0.f};
    bf16x8 At[4][2], B0[2][2], B1[2][2];
    const char* cA = (const char*)g.A + (size_t)(PLOCAL ? 0 : cur.pm) * tstep; const char* cB = (const char*)g.Bt + (size_t)(PLOCAL ? 0 : cur.pn) * tstep;
    S.a_ready(cur);
    if constexpr (SP2) {
        PG8_STAGE(PG8_SB(0, 0), cB, voffB); PG8_STAGE(PG8_SB(0, 1), cB + hstep, voffB); PG8_STAGE(PG8_SA(0, 0), cA, voffA); PG8_STAGE(PG8_SA(0, 1), cA + hstep, voffA);
        if (wr == 1) PG8_BAR;
        PG8_WAIT_V(2); PG8_BAR;
        PG8_STAGE(PG8_SB(1, 0), cB + kstep, voffB); PG8_STAGE(PG8_SA(1, 0), cA + kstep, voffA); PG8_STAGE(PG8_SB(1, 1), cB + hstep + kstep, voffB);
        PG8_WAIT_V(6); PG8_BAR;
    } else {
        PG8_STAGE(PG8_SB(0, 0), cB, voffB); PG8_STAGE(PG8_SA(0, 0), cA, voffA); PG8_STAGE(PG8_SB(0, 1), cB + hstep, voffB); PG8_STAGE(PG8_SA(0, 1), cA + hstep, voffA);
        if (wr == 1) PG8_BAR;
        PG8_WAIT_V(4); PG8_BAR;
        PG8_STAGE(PG8_SB(1, 0), cB + kstep, voffB); PG8_STAGE(PG8_SA(1, 0), cA + kstep, voffA); PG8_STAGE(PG8_SB(1, 1), cB + hstep + kstep, voffB);
        PG8_WAIT_V(6); PG8_BAR;
    }
    for (;;) {
        const bool has_next = S.next(ui + 1, nxt);
        const char* nA = has_next ? (const char*)g.A + (size_t)(PLOCAL ? 0 : nxt.pm) * tstep : cA; const char* nB = has_next ? (const char*)g.Bt + (size_t)(PLOCAL ? 0 : nxt.pn) * tstep : cB;
        for (int t = 0; t < nt; t += 2) {
            const bool last = (t == nt - 2);
            const char* a1 = cA + (size_t)(t + 1) * kstep;
            const char* a2 = last ? nA : cA + (size_t)(t + 2) * kstep; const char* b2 = last ? nB : cB + (size_t)(t + 2) * kstep;
            const char* a3 = a2 + kstep; const char* b3 = b2 + kstep;
            if (last && has_next) S.a_ready(nxt);
            if constexpr (SP2) {
            PG8_LDB(B0, 0, 0); PG8_LDB(B1, 0, 1); PG8_SCHED; PG8_LDA(At, 0, 0); PG8_STAGE(PG8_SA(1, 1), a1 + hstep, voffA);
            PG8_WAIT_V(8); PG8_WAIT_L(0); PG8_BAR; PG8_MMA(0, 0, At, B0); PG8_MMA(0, 1, At, B1); PG8_BAR; PG8_SCHED;
            PG8_LDA(At, 0, 1); PG8_STAGE(PG8_SB(0, 0), b2, voffB); PG8_STAGE(PG8_SB(0, 1), b2 + hstep, voffB); PG8_STAGE(PG8_SA(0, 0), a2, voffA);
            PG8_WAIT_V(8); PG8_WAIT_L(0); PG8_BAR; PG8_MMA(1, 0, At, B0); PG8_MMA(1, 1, At, B1); PG8_BAR; PG8_SCHED;
            PG8_LDB(B0, 1, 0); PG8_LDB(B1, 1, 1); PG8_SCHED; PG8_LDA(At, 1, 0); PG8_STAGE(PG8_SA(0, 1), a2 + hstep, voffA);
            PG8_WAIT_V(8); PG8_WAIT_L(0); PG8_BAR; PG8_MMA(0, 0, At, B0); PG8_MMA(0, 1, At, B1); PG8_BAR; PG8_SCHED;
            PG8_LDA(At, 1, 1); PG8_STAGE(PG8_SB(1, 0), b3, voffB); PG8_STAGE(PG8_SB(1, 1), b3 + hstep, voffB); PG8_STAGE(PG8_SA(1, 0), a3, voffA);
            PG8_WAIT_V(8); PG8_WAIT_L(0); PG8_BAR; PG8_MMA(1, 0, At, B0); PG8_MMA(1, 1, At, B1); PG8_BAR; PG8_SCHED;
            } else {
            PG8_LDB(B0, 0, 0); PG8_SCHED; PG8_LDA(At, 0, 0); PG8_STAGE(PG8_SA(1, 1), a1 + hstep, voffA);
            PG8_WAIT_L(8); PG8_BAR; PG8_WAIT_L(0); PG8_MMA(0, 0, At, B0); PG8_BAR; PG8_SCHED;
            PG8_LDB(B1, 0, 1); PG8_STAGE(PG8_SB(0, 0), b2, voffB);
            PG8_BAR; PG8_WAIT_L(0); PG8_MMA(0, 1, At, B1); PG8_BAR;
            PG8_LDA(At, 0, 1); PG8_STAGE(PG8_SA(0, 0), a2, voffA);
            PG8_BAR; PG8_WAIT_L(0); PG8_MMA(1, 0, At, B0); PG8_BAR; PG8_SCHED;
            PG8_STAGE(PG8_SB(0, 1), b2 + hstep, voffB);
            PG8_WAIT_V(6); PG8_BAR; PG8_MMA(1, 1, At, B1); PG8_BAR;
            PG8_LDB(B0, 1, 0); PG8_SCHED; PG8_LDA(At, 1, 0); PG8_STAGE(PG8_SA(0, 1), a2 + hstep, voffA);
            PG8_WAIT_L(8); PG8_BAR; PG8_WAIT_L(0); PG8_MMA(0, 0, At, B0); PG8_BAR; PG8_SCHED;
            PG8_LDB(B1, 1, 1); PG8_STAGE(PG8_SB(1, 0), b3, voffB);
            PG8_BAR; PG8_WAIT_L(0); PG8_MMA(0, 1, At, B1); PG8_BAR;
            PG8_LDA(At, 1, 1); PG8_STAGE(PG8_SA(1, 0), a3, voffA);
            PG8_BAR; PG8_WAIT_L(0); PG8_MMA(1, 0, At, B0); PG8_BAR; PG8_SCHED;
            PG8_STAGE(PG8_SB(1, 1), b3 + hstep, voffB);
            PG8_WAIT_V(6); PG8_BAR; PG8_MMA(1, 1, At, B1); PG8_BAR;
            }
        }
        if constexpr (ALIGN_EPI) { if (wr == 0) PG8_BAR; }
        if constexpr (!Epi::AFTER_DRAIN) { E(acc, cur, wr, wc, fr, fq); S.done(cur); }
        if (!has_next) break;
#pragma unroll
        for (int a = 0; a < 2; ++a)
#pragma unroll
            for (int b = 0; b < 2; ++b)
#pragma unroll
                for (int m = 0; m < 4; ++m)
#pragma unroll
                    for (int n = 0; n < 2; ++n) acc[a][b][m][n] = (f32x4){0.f, 0.f, 0.f, 0.f};
        cur = nxt; cA = nA; cB = nB; ++ui;
        if constexpr (ALIGN_EPI) { if (wr == 1) PG8_BAR; }
    }
    PG8_WAIT_V(0);
    if constexpr (!ALIGN_EPI) { if (wr == 0) PG8_BAR; }
    PG8_BAR;
    if constexpr (Epi::AFTER_DRAIN) { E.fused(acc, cur, wr, wc, fr, fq, lds, wid, lane); S.done(cur); }
#undef PG8_SA
#undef PG8_SB
#undef PG8_STAGE
#undef PG8_LDA
#undef PG8_LDB
#undef PG8_MMA
#undef PG8_WAIT_V
#undef PG8_WAIT_L
#undef PG8_BAR
#undef PG8_SCHED
}
}

#ifndef PG8_SP2
#define PG8_SP2 true
#endif
#ifndef PG8_ALIGN
#define PG8_ALIGN true
#endif
constexpr int NWAVES = 8;
#ifndef MK_N_LAUNCHES
#define MK_N_LAUNCHES 1
#endif
constexpr int N_PHASES = 8;
constexpr int N_LAUNCHES = MK_N_LAUNCHES;

constexpr int BATCH = 4, SEQ = 4096, D = 4096, NMETA = 16;
constexpr int M = BATCH * SEQ;
constexpr int D_SSM = 1024, NGRP = 64, SGRP = 16, NSTATE = 64;
constexpr int NH = 16, HD = 64, VD = 128, QKW = 2048, DATT = 2048;
constexpr int D_IN = 15360, D_FF = 11008;
constexpr int KVROWS = SEQ + 64;
constexpr float EPS = 1e-6f;
constexpr float LAMBDA_INIT = 0.2f;
constexpr float LOG2E = 1.4426950408889634f;

constexpr size_t MiB = 1u << 20;
constexpr size_t WS_CTL = 0, CTL_ZERO_BYTES = 1 * MiB;
constexpr size_t WS_WIN = 2 * MiB, WS_WGLU = 122 * MiB, WS_WBRA = 124 * MiB, WS_WBRB = 132 * MiB, WS_WO = 148 * MiB, WS_WGU = 180 * MiB, WS_WDN = 352 * MiB;
constexpr size_t WS_HN = 438 * MiB;
constexpr size_t WS_TM = 566 * MiB;
constexpr size_t WS_U = 694 * MiB, WS_Q = 726 * MiB, WS_K = 790 * MiB, WS_V = 855 * MiB, WS_GS = 920 * MiB, WS_GA = 1048 * MiB;
constexpr size_t WS_ACT = 694 * MiB;
constexpr size_t WS_G = 1176 * MiB, WS_YSSM = 1208 * MiB;
constexpr size_t WS_PS = 1240 * MiB;
constexpr size_t WS_HNM = 1244 * MiB, WS_UM = 1245 * MiB;
constexpr size_t WS_KM = 1246 * MiB, WS_W8 = 1249 * MiB, WS_G8 = 1251 * MiB, WS_SSMF = 1253 * MiB;
constexpr size_t WS_END = 1290 * MiB;
static_assert(WS_WIN + (size_t)D_IN * D * 2 <= WS_WGLU && WS_WGU + (size_t)2 * D_FF * D * 2 <= WS_WDN && WS_WDN + (size_t)D * D_FF * 2 <= WS_HN, "weights map");
static_assert(WS_K + (size_t)BATCH * KVROWS * QKW * 2 <= WS_V && WS_V + (size_t)BATCH * KVROWS * DATT * 2 <= WS_GS && WS_ACT + (size_t)M * D_FF * 2 <= WS_GA, "activation map");
constexpr int CW_TMO = 0, CW_CODE = 1;
constexpr int CW_BAR = 4096;

constexpr int RING_OFF = 0, RING_BYTES = 131072;
constexpr int LDS_BYTES = 147456;
constexpr int BIG_BYTES = LDS_BYTES - 1024;
constexpr int LDSCTL_OFF = BIG_BYTES, MISC_OFF = LDSCTL_OFF + 320;
static_assert(MISC_OFF + 128 <= LDS_BYTES, "LDS map");
#define GAS __attribute__((address_space(1)))
#define LAS __attribute__((address_space(3)))
typedef unsigned short bf16;
typedef unsigned v4u __attribute__((ext_vector_type(4)));
typedef float f32x4 __attribute__((ext_vector_type(4)));
typedef short bf16x8 __attribute__((ext_vector_type(8)));
typedef GAS unsigned gu32;
typedef GAS unsigned long long gu64;
#define RLX_AGENT __ATOMIC_RELAXED, __HIP_MEMORY_SCOPE_AGENT
#define LDS_WAIT() asm volatile("s_waitcnt lgkmcnt(0)" ::: "memory")
#define VM_WAIT() asm volatile("s_waitcnt vmcnt(0)" ::: "memory")
__device__ __forceinline__ unsigned long long rt() { return __builtin_amdgcn_s_memrealtime(); }
__device__ __forceinline__ unsigned f2bf(float f) { unsigned u = __builtin_bit_cast(unsigned, f); return (u + 0x7fffu + ((u >> 16) & 1u)) >> 16; }
__device__ __forceinline__ unsigned pk2(float lo, float hi) { return f2bf(lo) | (f2bf(hi) << 16); }

#define XB_TMO      128
#define XB_XCNT(j)  (256  + 64 * (j))
#define XB_XSUB(j)  (1280 + 64 * (j))
#define XB_XGEN(j)  (2304 + 64 * (j))
#define XB_TOP      3328
#define XB_TOPGEN   3392
#define XCD_BAR_WORDS 3456
#define XB_SPIN_CAP (1u << 18)

__device__ __forceinline__ unsigned xb_ld(unsigned* p)              { return __hip_atomic_load(p, __ATOMIC_RELAXED, __HIP_MEMORY_SCOPE_AGENT); }
__device__ __forceinline__ unsigned xb_add(unsigned* p, unsigned v) { return __hip_atomic_fetch_add(p, v, __ATOMIC_RELAXED, __HIP_MEMORY_SCOPE_AGENT); }
__device__ __forceinline__ unsigned xb_xcc_id() { return (unsigned)__builtin_amdgcn_s_getreg((3 << 11) | 20) & 0xFu; }
#define XB_SPIN(cond, bar) do { unsigned _sp = 0; while (cond) { __builtin_amdgcn_s_sleep(1); \
    if ((++_sp & 255u) == 0u) { if (xb_ld(&(bar)[XB_TMO])) break; if (_sp > XB_SPIN_CAP) { atomicAdd(&(bar)[XB_TMO], 1u); break; } } } } while (0)

struct XcdBarrier {
    unsigned* bar; unsigned x;
    volatile LAS unsigned* st;
};

__device__ __forceinline__ XcdBarrier xcd_barrier_post(unsigned* bar, volatile LAS unsigned* st) {
    XcdBarrier b; b.bar = bar; b.x = xb_xcc_id(); b.st = st;
    if (threadIdx.x == 0) (void)xb_add(&bar[XB_XCNT(b.x)], 1u);
    return b;
}
__device__ __forceinline__ void xcd_barrier_complete(unsigned* bar, unsigned x, unsigned& nloc, unsigned& nx) {
    const unsigned G = gridDim.x * gridDim.y * gridDim.z;
    unsigned sum, cnt, mine, sp = 0u;
    for (;;) {
        sum = 0u; cnt = 0u; mine = 0u;
#pragma unroll
        for (unsigned j = 0; j < 16; ++j) { const unsigned c = xb_ld(&bar[XB_XCNT(j)]); sum += c; cnt += (c > 0u) ? 1u : 0u; mine = (j == x) ? c : mine; }
        if (sum == G) break;
        __builtin_amdgcn_s_sleep(1);
        if ((++sp & 255u) == 0u) { if (xb_ld(&bar[XB_TMO])) break; if (sp > XB_SPIN_CAP) { atomicAdd(&bar[XB_TMO], 1u); break; } }
    }
    nloc = mine > 0u ? mine : 1u; nx = cnt > 0u ? cnt : 1u;
}

__device__ __forceinline__ void xcd_barrier(const XcdBarrier& b) {
    asm volatile("s_waitcnt vmcnt(0)" ::: "memory");
    __syncthreads();
    if (threadIdx.x == 0) {
        unsigned* bar = b.bar;
        __builtin_amdgcn_s_waitcnt(0);
        unsigned nloc = b.st[0], nx = b.st[1];
        if (nloc == 0u) { xcd_barrier_complete(bar, b.x, nloc, nx); b.st[0] = nloc; b.st[1] = nx; }
        const unsigned old = xb_add(&bar[XB_XSUB(b.x)], 1u);
        const unsigned gen = old / nloc;
        if (old + 1u == (gen + 1u) * nloc) {
            __builtin_amdgcn_fence(__ATOMIC_RELEASE, "agent");
            asm volatile("s_waitcnt vmcnt(0)" ::: "memory");
            const unsigned og = xb_add(&bar[XB_TOP], 1u);
            const unsigned tg = og / nx;
            if (og + 1u == (tg + 1u) * nx) xb_add(&bar[XB_TOPGEN], 1u);
            else XB_SPIN(xb_ld(&bar[XB_TOPGEN]) == tg, bar);
            __builtin_amdgcn_fence(__ATOMIC_ACQUIRE, "agent");
            xb_add(&bar[XB_XGEN(b.x)], 1u);
            asm volatile("s_waitcnt vmcnt(0)" ::: "memory");
        } else {
            XB_SPIN(xb_ld(&bar[XB_XGEN(b.x)]) == gen, bar);
            __builtin_amdgcn_fence(__ATOMIC_ACQUIRE, "agent");
            asm volatile("s_waitcnt vmcnt(0)" ::: "memory");
        }
    }
    __syncthreads();
}
struct Frame {
    LAS unsigned char* lds;
    volatile LAS unsigned* MISC;
    gu32* ctl;
    int tid, lane, wave;
    int vcu, G;
    const float* in[27]; float* out; unsigned char* ws;
    bf16 *WinT, *WgluT, *WbraT, *WbrbT, *WoT, *WguT, *WdnT;
    bf16 *HN, *TM, *U, *Q, *K, *V, *GS, *GA, *ACT, *Gb, *YSSM, *HNM, *UM, *KM, *W8, *G8; float *PS, *SSMF;
};
enum { I_X = 0, I_META, I_RELB, I_LN1G, I_WIN, I_QG, I_KG, I_LQ1, I_LK1, I_LQ2, I_LK2, I_SUBG, I_LRE, I_LIM, I_LOGDT, I_BRE, I_BIM, I_CRE, I_CIM, I_DSKIP, I_WGLU, I_BGLU, I_WBR, I_WO, I_LN2G, I_WGU, I_WDN };

__device__ __forceinline__ float wave_sum(float v) {
#pragma unroll
    for (int o = 1; o < 64; o <<= 1) v += __shfl_xor(v, o);
    return v;
}
__device__ __forceinline__ float wave_max(float v) {
#pragma unroll
    for (int o = 1; o < 64; o <<= 1) v = fmaxf(v, __shfl_xor(v, o));
    return v;
}
__device__ __forceinline__ float bf_lo(unsigned w) { return __uint_as_float(w << 16); }
__device__ __forceinline__ float bf_hi(unsigned w) { return __uint_as_float(w & 0xffff0000u); }

enum { RM_ID = 0, RM_IN = 1, RM_GU = 2 };
__device__ __forceinline__ int rowmap(int mode, int n) {
    if (mode == RM_IN) { if (n >= 1024 && n < 5120) { const int base = n - 1024, tile = base >> 8, c = base & 255, w = c >> 6, i = c & 63; return 1024 + tile * 256 + (i >> 5) * 128 + w * 32 + (i & 31); } return n; }
    if (mode == RM_GU) { const int up = n >= D_FF ? 1 : 0; const int j = up ? n - D_FF : n; return (j >> 7) * 256 + up * 128 + (j & 127); }
    return n;
}
__device__ __forceinline__ void p0_transpose_item(const float* W, int K, int N, bf16* WT, int mode, const float* ksc, LAS float* scr, int item, int lane) {
    const int nblk = N / 64, kb = item / nblk, nb = item % nblk, k0 = 64 * kb, n0 = 64 * nb;
    const int kk = lane >> 4, nq = lane & 15;
    f32x4 v[16];
#pragma unroll
    for (int i = 0; i < 16; ++i) v[i] = *(const GAS f32x4*)(W + (size_t)(k0 + 4 * i + kk) * N + n0 + 4 * nq);
    if (ksc) {
#pragma unroll
        for (int i = 0; i < 16; ++i) v[i] = v[i] * ksc[k0 + 4 * i + kk]; }
#pragma unroll
    for (int i = 0; i < 16; ++i) { const int k = 4 * i + kk; *(LAS f32x4*)(scr + k * 64 + 4 * (nq ^ ((k >> 3) & 7))) = v[i]; }
    LDS_WAIT(); asm volatile("" ::: "memory");
    const int c = lane & 7;
#pragma unroll
    for (int j = 0; j < 8; ++j) { const int n = (lane >> 3) + 8 * j; const LAS float* s = scr + (8 * c) * 64 + 4 * ((n >> 2) ^ c) + (n & 3);
        v4u o; o.x = pk2(s[0 * 64], s[1 * 64]); o.y = pk2(s[2 * 64], s[3 * 64]); o.z = pk2(s[4 * 64], s[5 * 64]); o.w = pk2(s[6 * 64], s[7 * 64]);
        *(GAS v4u*)(WT + (size_t)rowmap(mode, n0 + n) * K + k0 + 8 * c) = o; }
    LDS_WAIT(); asm volatile("" ::: "memory");
}
__device__ __forceinline__ void rms_row_to_bf16(const float* xrow, const float* g, bf16* orow, int lane) {
    f32x4 v[8][2]; float s = 0.f;
#pragma unroll
    for (int j = 0; j < 8; ++j) { const GAS f32x4* p = (const GAS f32x4*)(xrow + 512 * j + 8 * lane); v[j][0] = p[0]; v[j][1] = p[1];
        s += ((v[j][0].x * v[j][0].x + v[j][0].y * v[j][0].y) + (v[j][0].z * v[j][0].z + v[j][0].w * v[j][0].w)) + ((v[j][1].x * v[j][1].x + v[j][1].y * v[j][1].y) + (v[j][1].z * v[j][1].z + v[j][1].w * v[j][1].w)); }
    const float r = 1.0f / sqrtf(wave_sum(s) * (1.0f / D) + EPS);
#pragma unroll
    for (int j = 0; j < 8; ++j) { const GAS f32x4* gp = (const GAS f32x4*)(g + 512 * j + 8 * lane); const f32x4 a = v[j][0] * r * gp[0], b = v[j][1] * r * gp[1];
        v4u o; o.x = pk2(a.x, a.y); o.y = pk2(a.z, a.w); o.z = pk2(b.x, b.y); o.w = pk2(b.z, b.w);
        *(GAS v4u*)(orow + 512 * j + 8 * lane) = o; }
}
constexpr int CW_QDN = 2240, CW_QTAIL = 2304;
__device__ __forceinline__ void pull_wdown_items(Frame& F) {
    constexpr int I_DN = (D_FF / 64) * (D / 64);
    LAS float* scr = (LAS float*)(F.lds + RING_OFF + F.wave * 16384);
    volatile LAS unsigned* slot = F.MISC + 14;
    __syncthreads();
    for (;;) {
        if (F.tid == 0) { unsigned idx = __hip_atomic_fetch_add(F.ctl + CW_QDN, 8u, RLX_AGENT); if (idx >= (unsigned)I_DN) idx = 0xffffffffu; *slot = idx; }
        __syncthreads();
        const unsigned idx = *slot;
        if (idx == 0xffffffffu) break;
        const int it = (int)idx + F.wave;
        if (it < I_DN) p0_transpose_item(F.in[I_WDN], D_FF, D, F.WdnT, RM_ID, nullptr, scr, it, F.lane);
        __syncthreads();
    }
    __syncthreads();
}
__device__ __forceinline__ void p0_prologue(Frame& F, int parts) {
    LAS float* scr = (LAS float*)(F.lds + RING_OFF + F.wave * 16384);
    const int gw = F.vcu * NWAVES + F.wave, NGW = F.G * NWAVES;
    constexpr int I_IN = (D / 64) * (D_IN / 64);
    if (parts & 1) for (int it = gw; it < I_IN; it += NGW) p0_transpose_item(F.in[I_WIN], D, D_IN, F.WinT, RM_IN, nullptr, scr, it, F.lane);
    if (parts & 2) for (int m = gw; m < M + NMETA; m += NGW) {
        if (m < M) rms_row_to_bf16(F.in[I_X] + (size_t)m * D, F.in[I_LN1G], F.HN + (size_t)m * D, F.lane);
        else rms_row_to_bf16(F.in[I_META] + (size_t)(m - M) * D, F.in[I_LN1G], F.HNM + (size_t)(m - M) * D, F.lane);
    }
}
constexpr int CW_QITEM = 2048, CW_ARR1 = 2112;
__device__ __forceinline__ void rest_item(Frame& F, LAS float* scr, int r) {
    constexpr int I_GLU = (D_SSM / 64) * (D_SSM / 64), I_BRA = (D_SSM / 64) * (D / 64), I_BRB = (DATT / 64) * (D / 64), I_O = (D / 64) * (D / 64);
    if (r < I_GLU) { p0_transpose_item(F.in[I_WGLU], D_SSM, D_SSM, F.WgluT, RM_ID, nullptr, scr, r, F.lane); return; } r -= I_GLU;
    if (r < I_BRA) { p0_transpose_item(F.in[I_WBR], D_SSM, D, F.WbraT, RM_ID, nullptr, scr, r, F.lane); return; } r -= I_BRA;
    if (r < I_BRB) { p0_transpose_item(F.in[I_WBR] + (size_t)D_SSM * D, DATT, D, F.WbrbT, RM_ID, nullptr, scr, r, F.lane); return; } r -= I_BRB;
    if (r < I_O) { p0_transpose_item(F.in[I_WO], D, D, F.WoT, RM_ID, nullptr, scr, r, F.lane); return; } r -= I_O;
    p0_transpose_item(F.in[I_WGU], D, 2 * D_FF, F.WguT, RM_GU, F.in[I_LN2G], scr, r, F.lane);
}
__device__ __forceinline__ void pull_rest_items(Frame& F, int opportunistic) {
    constexpr int NITEMS = (D_SSM / 64) * (D_SSM / 64) + (D_SSM / 64) * (D / 64) + (DATT / 64) * (D / 64) + (D / 64) * (D / 64) + (D / 64) * (2 * D_FF / 64);
    LAS float* scr = (LAS float*)(F.lds + RING_OFF + F.wave * 16384);
    volatile LAS unsigned* slot = F.MISC + 12;
    __syncthreads();
    for (;;) {
        if (F.tid == 0) { unsigned idx = 0xffffffffu;
            const bool stop = opportunistic && __hip_atomic_load(F.ctl + CW_ARR1, RLX_AGENT) >= (unsigned)F.G;
            if (!stop) { idx = __hip_atomic_fetch_add(F.ctl + CW_QITEM, 8u, RLX_AGENT); if (idx >= (unsigned)NITEMS) idx = 0xffffffffu; }
            *slot = idx; }
        __syncthreads();
        const unsigned idx = *slot;
        if (idx == 0xffffffffu) break;
        const int it = (int)idx + F.wave;
        if (it < NITEMS) rest_item(F, scr, it);
        __syncthreads();
    }
    __syncthreads();
}

__device__ __forceinline__ void pull_rest_half(Frame& F, unsigned num = 1u, unsigned den = 2u, unsigned limit = 0xffffffffu) {
    constexpr int NITEMS = (D_SSM / 64) * (D_SSM / 64) + (D_SSM / 64) * (D / 64) + (DATT / 64) * (D / 64) + (D / 64) * (D / 64) + (D / 64) * (2 * D_FF / 64);
    LAS float* scr = (LAS float*)(F.lds + RING_OFF + F.wave * 16384);
    volatile LAS unsigned* slot = F.MISC + 12;
    unsigned target = 0;
    if (F.tid == 0) { const unsigned h0 = __hip_atomic_load(F.ctl + CW_QITEM, RLX_AGENT); const unsigned lim = limit < (unsigned)NITEMS ? limit : (unsigned)NITEMS; target = h0 >= lim ? 0u : h0 + (lim - h0) * num / den; }
    __syncthreads();
    for (;;) {
        if (F.tid == 0) { unsigned idx = 0xffffffffu;
            if (__hip_atomic_load(F.ctl + CW_QITEM, RLX_AGENT) < target) { idx = __hip_atomic_fetch_add(F.ctl + CW_QITEM, 8u, RLX_AGENT); if (idx >= (unsigned)NITEMS) idx = 0xffffffffu; }
            *slot = idx; }
        __syncthreads();
        const unsigned idx = *slot;
        if (idx == 0xffffffffu) break;
        const int it = (int)idx + F.wave;
        if (it < NITEMS) rest_item(F, scr, it);
        __syncthreads();
    }
    __syncthreads();
}

constexpr int N_REST_ALL = (D_SSM / 64) * (D_SSM / 64) + (D_SSM / 64) * (D / 64) + (DATT / 64) * (D / 64) + (D / 64) * (D / 64) + (D / 64) * (2 * D_FF / 64);
constexpr int N_REST_NOGU = N_REST_ALL - (D / 64) * (2 * D_FF / 64);
__device__ __forceinline__ void pull_rest_until(Frame& F, int limit) {
    LAS float* scr = (LAS float*)(F.lds + RING_OFF + F.wave * 16384);
    volatile LAS unsigned* slot = F.MISC + 12;
    __syncthreads();
    for (;;) {
        if (F.tid == 0) { unsigned idx = 0xffffffffu;
            if (__hip_atomic_load(F.ctl + CW_QITEM, RLX_AGENT) < (unsigned)limit) { idx = __hip_atomic_fetch_add(F.ctl + CW_QITEM, 8u, RLX_AGENT); if (idx >= (unsigned)N_REST_ALL) idx = 0xffffffffu; }
            *slot = idx; }
        __syncthreads();
        const unsigned idx = *slot;
        if (idx == 0xffffffffu) break;
        const int it = (int)idx + F.wave;
        if (it < N_REST_ALL) rest_item(F, scr, it);
        __syncthreads();
    }
    __syncthreads();
}

__device__ __forceinline__ void meta_tile(Frame& F, int t) {
        const int lane = F.lane, w = F.wave, l15 = lane & 15, kq = lane >> 4;
        const int type = t < 16 ? 0 : (t < 48 ? 1 : 2), Gi = t - (type == 0 ? 0 : (type == 1 ? 16 : 48));
        const bf16* arow[4];
#pragma unroll
        for (int sb = 0; sb < 4; ++sb) { const int c = 16 * sb + l15;
            const int row = type == 0 ? 64 * Gi + c : (type == 1 ? 3072 + (Gi >> 2) * 256 + (c >> 5) * 128 + (Gi & 3) * 32 + (c & 31) : 5120 + 64 * Gi + c);
            arow[sb] = F.WinT + (size_t)row * D + w * 512 + 8 * kq; }
        const bf16* brow = F.HNM + (size_t)l15 * D + w * 512 + 8 * kq;
        f32x4 acc[4];
#pragma unroll
        for (int sb = 0; sb < 4; ++sb) acc[sb] = (f32x4){0.f, 0.f, 0.f, 0.f};
#pragma unroll 4
        for (int ks = 0; ks < 16; ++ks) { const bf16x8 b = *(const bf16x8*)(brow + 32 * ks);
#pragma unroll
            for (int sb = 0; sb < 4; ++sb) { const bf16x8 a = *(const bf16x8*)(arow[sb] + 32 * ks); acc[sb] = __builtin_amdgcn_mfma_f32_16x16x32_bf16(a, b, acc[sb], 0, 0, 0); } }
        LAS f32x4* part = (LAS f32x4*)(F.lds + RING_OFF);
#pragma unroll
        for (int sb = 0; sb < 4; ++sb) part[(w * 4 + sb) * 64 + lane] = acc[sb];
        __syncthreads();
        if (F.tid < 256) {
            const int j = F.tid >> 4, cq = F.tid & 15, l = j + 16 * (cq & 3), sb = cq >> 2;
            f32x4 v = (f32x4){0.f, 0.f, 0.f, 0.f};
#pragma unroll
            for (int w2 = 0; w2 < 8; ++w2) v += part[(w2 * 4 + sb) * 64 + l];
            if (type == 1) { float ss = (v.x * v.x + v.y * v.y) + (v.z * v.z + v.w * v.w);
                ss += __shfl_xor(ss, 1); ss += __shfl_xor(ss, 2); ss += __shfl_xor(ss, 4); ss += __shfl_xor(ss, 8);
                const float r = 1.0f / sqrtf(ss * (1.0f / 64.0f) + EPS); const f32x4 gn = *(const f32x4*)(F.in[I_KG] + 4 * cq); v = v * r * gn; }
            uint2 o; o.x = pk2(v.x, v.y); o.y = pk2(v.z, v.w);
            if (type == 0) *(uint2*)(F.UM + j * D_SSM + 64 * Gi + 4 * cq) = o;
            else { bf16* base = type == 1 ? F.K : F.V;
#pragma unroll
                for (int b = 0; b < BATCH; ++b) *(uint2*)(base + (size_t)(b * KVROWS + 48 + j) * 2048 + 64 * Gi + 4 * cq) = o; }
        }
    __syncthreads();
}
constexpr int CW_QMETA = 2176;
__device__ __forceinline__ void meta_proj(Frame& F) {
    { const int nth = (int)gridDim.x * NWAVES * 64;
      for (int i = (int)blockIdx.x * NWAVES * 64 + F.tid; i < 2 * BATCH * 48 * 256; i += nth) {
          const int tensor = i / (BATCH * 48 * 256), r = i % (BATCH * 48 * 256), b = r / (48 * 256), rr = (r % (48 * 256)) / 256, ch = r % 256;
          bf16* p = (tensor ? F.V : F.K) + (size_t)(b * KVROWS + rr) * 2048 + ch * 8;
          *(v4u*)p = (v4u){0u, 0u, 0u, 0u}; } }
    volatile LAS unsigned* slot = F.MISC + 13;
    __syncthreads();
    for (;;) {
        if (F.tid == 0) *slot = __hip_atomic_fetch_add(F.ctl + CW_QMETA, 1u, RLX_AGENT);
        __syncthreads();
        const unsigned t = *slot;
        if (t >= 80u) break;
        meta_tile(F, (int)t);
    }
    __syncthreads();
}

__device__ __forceinline__ float gelu_tanh(float x) { const float z = 0.7978845608028654f * (x + 0.044715f * x * x * x); const float e = __expf(2.0f * z); return 0.5f * x * (2.0f - 2.0f / (e + 1.0f)); }
constexpr int BB_LD = 132;
__device__ __forceinline__ float diff_lambda(Frame& F) {
    const float s1 = wave_sum(F.in[I_LQ1][F.lane] * F.in[I_LK1][F.lane]), s2 = wave_sum(F.in[I_LQ2][F.lane] * F.in[I_LK2][F.lane]);
    return expf(s1) - expf(s2) + LAMBDA_INIT;
}
namespace att {
typedef float f32x16 __attribute__((ext_vector_type(16)));
typedef short s16x4 __attribute__((ext_vector_type(4)));
typedef short v4i16_t __attribute__((ext_vector_type(4)));
typedef LAS const char* lds_cptr;
typedef unsigned u32x4 __attribute__((ext_vector_type(4)));
constexpr int SLOT = 16384, NSLOT = 4, L_K = 0, L_V = NSLOT * SLOT, L_BB = 2 * NSLOT * SLOT, L_WS = L_BB + 8704, L_END = L_WS + NWAVES * 256;
constexpr int L_X = 0, L_STG = L_V;
static_assert(NH * BB_LD * 4 <= 8704 && L_END <= BIG_BYTES && 4 * 16384 <= NSLOT * SLOT, "attention LDS map");
__device__ __forceinline__ int crow(int r, int hi) { return (r & 3) + 8 * (r >> 2) + 4 * hi; }
__device__ __forceinline__ void glds16(const void* gsrc, unsigned lds_dst) { unsigned keep;
    asm volatile("s_mov_b32 %0, m0\n\ts_mov_b32 m0, %2\n\ts_nop 0\n\tglobal_load_lds_dwordx4 %1, off\n\ts_mov_b32 m0, %0" : "=&s"(keep) : "v"(gsrc), "s"(lds_dst) : "memory"); }
__device__ __forceinline__ s16x4 vtr(lds_cptr p) { return __builtin_bit_cast(s16x4, __builtin_amdgcn_ds_read_tr16_b64_v4i16((LAS v4i16_t*)p)); }
__device__ __forceinline__ unsigned cvtpk(float lo, float hi) { typedef float f2 __attribute__((ext_vector_type(2))); typedef __bf16 b2 __attribute__((ext_vector_type(2))); f2 v = {lo, hi}; b2 b = __builtin_convertvector(v, b2); return __builtin_bit_cast(unsigned, b); }
#define ATT_WAIT_BAR() asm volatile("s_waitcnt vmcnt(0) lgkmcnt(0)\n\ts_barrier" ::: "memory")

__device__ __forceinline__ void build_rel_bias_table(Frame& F, LAS float* bbt) {
    const float* rb = F.in[I_RELB];
    for (int idx = F.tid; idx < NH * 129; idx += NWAVES * 64) { const int h = idx / 129, d = idx % 129;
        int bucket = d; if (d >= 16) { bucket = 16 + (int)(logf((float)d * (1.0f / 16.0f)) / 2.0794415416798357f * 16.0f); bucket = bucket > 31 ? 31 : bucket; }
        bbt[h * BB_LD + d] = (rb[bucket * NH + h] - rb[31 * NH + h]) * LOG2E; }
    for (int h = F.tid; h < NH; h += NWAVES * 64) bbt[h * BB_LD + 129] = -1e30f;
}
__device__ __forceinline__ void qk_half(f32x16& s, lds_cptr kp, const int (&ko)[4], const bf16x8 (&qr)[4]) {
    const f32x16 z = {0.f, 0.f, 0.f, 0.f, 0.f, 0.f, 0.f, 0.f, 0.f, 0.f, 0.f, 0.f, 0.f, 0.f, 0.f, 0.f};
#pragma unroll
    for (int d0 = 0; d0 < 4; ++d0) { const bf16x8 a = *(const LAS bf16x8*)(kp + ko[d0]); s = __builtin_amdgcn_mfma_f32_32x32x16_bf16(a, qr[d0], d0 == 0 ? z : s, 0, 0, 0); }
}
__device__ __forceinline__ void band_fix(f32x16& s, const LAS float* bb, int dbase, int pos4) {
#pragma unroll
    for (int r = 0; r < 16; ++r) { const int ko = (r & 3) + 8 * (r >> 2);
        const int dist = dbase - ko, pos = pos4 + ko; const bool valid = dist >= 0 && pos >= -NMETA; const int idx = valid ? (dist > 128 ? 128 : dist) : 129;
        s[r] += bb[idx]; }
}
__device__ __forceinline__ void exp_pack(f32x16& s, float& l, u32x4& pa, u32x4& pb) {
    float acc = 0.f;
#pragma unroll
    for (int r = 0; r < 16; ++r) { s[r] = __builtin_amdgcn_exp2f(s[r]); acc += s[r]; }
    l += acc;
    pa = (u32x4){cvtpk(s[0], s[1]), cvtpk(s[2], s[3]), cvtpk(s[4], s[5]), cvtpk(s[6], s[7])};
    pb = (u32x4){cvtpk(s[8], s[9]), cvtpk(s[10], s[11]), cvtpk(s[12], s[13]), cvtpk(s[14], s[15])};
}
#define ATT_SB() do {} while (0)
__device__ __forceinline__ void v_frags(bf16x8 (&vf)[4], lds_cptr vp, int eb) {
#pragma unroll
    for (int ks = 0; ks < 4; ++ks) { const s16x4 lo = vtr(vp + (eb >> 1) * 8192 + (eb & 1) * 512 + ks * 2048), hh = vtr(vp + (eb >> 1) * 8192 + (eb & 1) * 512 + ks * 2048 + 1024);
        vf[ks] = (bf16x8){lo[0], lo[1], lo[2], lo[3], hh[0], hh[1], hh[2], hh[3]}; }
}
__device__ __forceinline__ void tile_compute(bool BAND, f32x16 (&O)[4], float& l, const bf16x8 (&q)[4], lds_cptr kp, const int (&ko)[4], lds_cptr vp, const LAS float* bb, int dbase, int pos4) {
    const f32x16 z = {0.f, 0.f, 0.f, 0.f, 0.f, 0.f, 0.f, 0.f, 0.f, 0.f, 0.f, 0.f, 0.f, 0.f, 0.f, 0.f};
    bf16x8 kf[8];
#pragma unroll
    for (int d0 = 0; d0 < 4; ++d0) { kf[d0] = *(const LAS bf16x8*)(kp + ko[d0]); kf[4 + d0] = *(const LAS bf16x8*)(kp + 8192 + ko[d0]); }
    bf16x8 va[4], vb[4];
    v_frags(va, vp, 0);
    __builtin_amdgcn_sched_barrier(0);
    f32x16 s0, s1;
#pragma unroll
    for (int d0 = 0; d0 < 4; ++d0) { s0 = __builtin_amdgcn_mfma_f32_32x32x16_bf16(kf[d0], q[d0], d0 == 0 ? z : s0, 0, 0, 0); s1 = __builtin_amdgcn_mfma_f32_32x32x16_bf16(kf[4 + d0], q[d0], d0 == 0 ? z : s1, 0, 0, 0); }
    u32x4 pa[4];
    if (BAND) { band_fix(s0, bb, dbase, pos4); band_fix(s1, bb, dbase - 32, pos4 + 32); }
    exp_pack(s0, l, pa[0], pa[1]); exp_pack(s1, l, pa[2], pa[3]);
    __builtin_amdgcn_sched_barrier(0);
    v_frags(vb, vp, 1);
#pragma unroll
    for (int ks = 0; ks < 4; ++ks) O[0] = __builtin_amdgcn_mfma_f32_32x32x16_bf16(__builtin_bit_cast(bf16x8, pa[ks]), va[ks], O[0], 0, 0, 0);
    __builtin_amdgcn_sched_barrier(0);
    v_frags(va, vp, 2);
#pragma unroll
    for (int ks = 0; ks < 4; ++ks) O[1] = __builtin_amdgcn_mfma_f32_32x32x16_bf16(__builtin_bit_cast(bf16x8, pa[ks]), vb[ks], O[1], 0, 0, 0);
    __builtin_amdgcn_sched_barrier(0);
    v_frags(vb, vp, 3);
#pragma unroll
    for (int ks = 0; ks < 4; ++ks) O[2] = __builtin_amdgcn_mfma_f32_32x32x16_bf16(__builtin_bit_cast(bf16x8, pa[ks]), va[ks], O[2], 0, 0, 0);
    __builtin_amdgcn_sched_barrier(0);
#pragma unroll
    for (int ks = 0; ks < 4; ++ks) O[3] = __builtin_amdgcn_mfma_f32_32x32x16_bf16(__builtin_bit_cast(bf16x8, pa[ks]), vb[ks], O[3], 0, 0, 0);
}
__device__ __forceinline__ void attn_unit(Frame& F, int b, int h, int qb, float lam, bf16* dst) {
    const int lane = F.lane, r32 = lane & 31, hi = lane >> 5, wid = F.wave, qblk = wid & 3, map = wid >> 2;
    const unsigned lds0 = (unsigned)(uintptr_t)(F.lds + RING_OFF);
    const lds_cptr L = (lds_cptr)(F.lds + RING_OFF);
    const int q0 = qb * 128, qmin = q0 + 32 * qblk, NT = 2 * qb + 3;
    const bf16* Kb = F.K + (size_t)(b * KVROWS) * QKW + h * 128; const bf16* Vb = F.V + (size_t)(b * KVROWS) * DATT + h * 128;
    const bf16* ksrc = Kb + (size_t)(4 * wid + (lane >> 4)) * QKW + (((lane & 15) ^ ((4 * wid + (lane >> 4)) & 15)) * 8);
    const bf16* vsrc = Vb + (size_t)(8 * wid + ((lane >> 2) & 7)) * DATT + (lane >> 5) * 32 + (lane & 3) * 8;
    const unsigned kdst = lds0 + L_K + wid * 1024, vdst = lds0 + L_V + wid * 1024;
#define ATT_DMA(T, slot) do { const size_t go_ = (size_t)(T) * 64 * QKW; const unsigned so_ = (unsigned)(slot) * SLOT; \
        glds16(ksrc + go_, (unsigned)__builtin_amdgcn_readfirstlane(kdst + so_)); glds16(ksrc + go_ + (size_t)32 * QKW, (unsigned)__builtin_amdgcn_readfirstlane(kdst + so_ + 8192)); \
        glds16(vsrc + go_, (unsigned)__builtin_amdgcn_readfirstlane(vdst + so_)); glds16(vsrc + go_ + 64, (unsigned)__builtin_amdgcn_readfirstlane(vdst + so_ + 8192)); } while (0)
    bf16* Qw = F.Q + (size_t)(b * SEQ + qmin + r32) * QKW + h * 128 + map * 64 + hi * 8;
    bf16x8 q[4];
#pragma unroll
    for (int d0 = 0; d0 < 4; ++d0) q[d0] = *(const bf16x8*)(Qw + d0 * 16);
#pragma unroll
    for (int d0 = 0; d0 < 4; ++d0) asm volatile("" : "+v"(q[d0]));
    asm volatile("s_waitcnt lgkmcnt(0)\n\ts_barrier" ::: "memory");
    ATT_DMA(0, 0); ATT_DMA(1, 1); ATT_DMA(2, 2);
    f32x16 O[4];
#pragma unroll
    for (int eb = 0; eb < 4; ++eb)
#pragma unroll
        for (int r = 0; r < 16; ++r) O[eb][r] = 0.f;
    float l = 0.f;
    const LAS float* bb = (const LAS float*)(F.lds + RING_OFF + L_BB) + h * BB_LD;
    const int vlane = ((lane >> 4) & 1) * 32 + (lane & 3) * 8 + (4 * hi + ((lane & 15) >> 2)) * 64;
    int ko[4];
#pragma unroll
    for (int d0 = 0; d0 < 4; ++d0) ko[d0] = r32 * 256 + (((map * 8 + 2 * d0 + hi) ^ (r32 & 15)) * 16);
    const int NTw = (qmin + 95) / 64 + 1 < NT ? (qmin + 95) / 64 + 1 : NT;
#define ATT_STEP_SYNC(T) do { if ((T) + 2 < NT) asm volatile("s_waitcnt vmcnt(8) lgkmcnt(0)\n\ts_barrier" ::: "memory"); \
        else if ((T) + 1 < NT) asm volatile("s_waitcnt vmcnt(4) lgkmcnt(0)\n\ts_barrier" ::: "memory"); \
        else asm volatile("s_waitcnt vmcnt(0) lgkmcnt(0)\n\ts_barrier" ::: "memory"); \
        if ((T) + 3 < NT) ATT_DMA((T) + 3, ((T) + 3) & 3); } while (0)
#pragma clang loop unroll(disable)
    for (int T = 0; T < NTw; ++T) {
        ATT_STEP_SYNC(T);
        const int pos0 = 64 * T - 64;
        const lds_cptr kp = L + L_K + (T & 3) * SLOT, vp = L + L_V + (T & 3) * SLOT + vlane;
        const bool band = !(T >= 1 && pos0 + 63 + 128 <= qmin);
        tile_compute(band, O, l, q, kp, ko, vp, bb, qmin + r32 - pos0 - 4 * hi, pos0 + 4 * hi);
    }
#pragma clang loop unroll(disable)
    for (int T = NTw; T < NT; ++T) ATT_STEP_SYNC(T);
#undef ATT_STEP_SYNC
#undef ATT_DMA
    l += __shfl_xor(l, 32);
    LAS float* wsf = (LAS float*)(F.lds + RING_OFF + L_WS) + wid * 64;
    if (hi == 0) wsf[r32] = (map ? lam : 1.0f) / l;
    asm volatile("s_waitcnt lgkmcnt(0)\n\ts_barrier" ::: "memory");
    float sc[16];
#pragma unroll
    for (int r = 0; r < 16; ++r) sc[r] = wsf[crow(r, hi)];
    LAS float* X = (LAS float*)(F.lds + RING_OFF + L_X) + qblk * 4096 + lane;
    if (map) {
#pragma unroll
        for (int eb = 0; eb < 4; ++eb)
#pragma unroll
            for (int r = 0; r < 16; ++r) X[(eb * 16 + r) * 64] = O[eb][r] * sc[r];
    }
    asm volatile("s_waitcnt lgkmcnt(0)\n\ts_barrier" ::: "memory");
    if (map == 0) {
        float ss[16];
#pragma unroll
        for (int r = 0; r < 16; ++r) { float s = 0.f;
#pragma unroll
            for (int eb = 0; eb < 4; ++eb) { const float o = O[eb][r] * sc[r] - X[(eb * 16 + r) * 64]; O[eb][r] = o; s += o * o; }
            ss[r] = s; }
#pragma unroll
        for (int r = 0; r < 16; ++r) { float s = ss[r]; s += __shfl_xor(s, 1); s += __shfl_xor(s, 2); s += __shfl_xor(s, 4); s += __shfl_xor(s, 8); s += __shfl_xor(s, 16);
            ss[r] = (1.0f - LAMBDA_INIT) / sqrtf(s * (1.0f / VD) + EPS); }
        float sg[4];
#pragma unroll
        for (int eb = 0; eb < 4; ++eb) sg[eb] = F.in[I_SUBG][32 * eb + r32];
        LAS bf16* stg = (LAS bf16*)(F.lds + RING_OFF + L_STG) + qblk * 2048;
        bf16* Ow = dst + (size_t)(b * SEQ + qmin) * QKW + h * 128;
#pragma unroll
        for (int half = 0; half < 2; ++half) {
#pragma unroll
            for (int r = 0; r < 16; ++r) { const int orow = crow(r, hi);
#pragma unroll
                for (int e2 = 0; e2 < 2; ++e2) { const int eb = 2 * half + e2; stg[orow * 64 + e2 * 32 + r32] = (bf16)f2bf(O[eb][r] * ss[r] * sg[eb]); } }
            asm volatile("s_waitcnt lgkmcnt(0)" ::: "memory");
#pragma unroll
            for (int i = 0; i < 4; ++i) { const int row = i * 8 + (lane >> 3), ch = lane & 7; const v4u v = *(const LAS v4u*)(stg + row * 64 + ch * 8); *(v4u*)(Ow + (size_t)row * QKW + half * 64 + ch * 8) = v; }
            asm volatile("s_waitcnt lgkmcnt(0)" ::: "memory");
        }
    }
}
__device__ __forceinline__ void attn_phase(Frame& F, bf16* dst) {
    build_rel_bias_table(F, (LAS float*)(F.lds + RING_OFF + L_BB));
    __syncthreads();
    const float lam = diff_lambda(F);
#pragma clang loop unroll(disable)
    for (int k = 0; ; ++k) { const int pr = F.vcu + (k >> 1) * F.G; if (pr >= BATCH * NH * 16) break;
        const int bh = pr >> 4, j = pr & 15;
        attn_unit(F, bh >> 4, bh & 15, (k & 1) ? j : 31 - j, lam, dst); }
    asm volatile("s_waitcnt vmcnt(0) lgkmcnt(0)" ::: "memory");
    __syncthreads();
}
}
namespace ssm {
constexpr int KM_ELEMS = 66 * 256, T8_ELEMS = 128 * 128, SF_STRIDE = 4608;
constexpr int SF_A = 0, SF_A8 = 128, SF_P64 = 256, SF_BB = 256 + 17 * 128;
static_assert(SF_BB + 64 * 16 * 2 <= SF_STRIDE, "ssm f32 table");
constexpr int L_KM = 0, L_US = 33792, L_SIN = L_US + 2 * 32768, L_END = L_SIN + 32768;
static_assert(KM_ELEMS * 2 <= L_US && L_END <= BIG_BYTES, "ssm LDS map");
typedef float f2 __attribute__((ext_vector_type(2)));
typedef unsigned u2v __attribute__((ext_vector_type(2)));
__device__ __forceinline__ f2 cmul(f2 a, f2 b) { return (f2){a.x * b.x - a.y * b.y, a.x * b.y + a.y * b.x}; }

__device__ __forceinline__ void p0_tables(Frame& F) {
    LAS f2* apw = (LAS f2*)(F.lds + RING_OFF);
    LAS f2* bbl = apw + 65 * 64;
    LAS f2* cl = bbl + 64 * 16;
    for (int gp = F.vcu; gp < NGRP * 4; gp += F.G) {
        const int g = gp >> 2, part = gp & 3;
        const double dt = exp((double)F.in[I_LOGDT][g]);
        __syncthreads();
        if (F.tid < 64) { const int p = F.tid;
            const double lre = F.in[I_LRE][g * 64 + p], lim = F.in[I_LIM][g * 64 + p], er = exp(lre * dt), ar = er * cos(lim * dt), ai = er * sin(lim * dt);
            double pr = 1.0, pi = 0.0, a64r = 1.0, a64i = 0.0;
            for (int n = 0; n <= 64; ++n) { apw[n * 64 + p] = (f2){(float)pr, (float)pi}; a64r = pr; a64i = pi; const double t = pr * ar - pi * ai; pi = pr * ai + pi * ar; pr = t; }
            if (part == 2) { float* sf = F.SSMF + (size_t)g * SF_STRIDE; double qr = 1.0, qi = 0.0;
                for (int n = 0; n <= 16; ++n) { ((f2*)(sf + SF_P64))[n * 64 + p] = (f2){(float)qr, (float)qi}; const double t = qr * a64r - qi * a64i; qi = qr * a64i + qi * a64r; qr = t; } } }
        for (int idx = F.tid; idx < 64 * 16; idx += NWAVES * 64) { const int p = idx >> 4, c = idx & 15;
            const double lre = F.in[I_LRE][g * 64 + p], lim = F.in[I_LIM][g * 64 + p], er = exp(lre * dt), ar = er * cos(lim * dt), ai = er * sin(lim * dt);
            const double nr = ar - 1.0, ni = ai, den = lre * lre + lim * lim, fr = (nr * lre + ni * lim) / den, fi = (ni * lre - nr * lim) / den;
            const double br = F.in[I_BRE][(g * 64 + p) * 16 + c], bi = F.in[I_BIM][(g * 64 + p) * 16 + c];
            bbl[idx] = (f2){(float)(fr * br - fi * bi), (float)(fr * bi + fi * br)}; }
        for (int idx = F.tid; idx < 16 * 64; idx += NWAVES * 64) { const int c = idx >> 6, p = idx & 63; cl[idx] = (f2){F.in[I_CRE][(g * 16 + c) * 64 + p], F.in[I_CIM][(g * 16 + c) * 64 + p]}; }
        __syncthreads();
        bf16* km = F.KM + (size_t)g * KM_ELEMS;
        for (int idx = F.tid; idx < 16 * 256; idx += NWAVES * 64) { const int lag = 16 * part + (idx >> 8), c = (idx >> 4) & 15, c2 = idx & 15; float s = 0.f;
            for (int p = 0; p < 64; ++p) { const f2 z = cmul(cl[c * 64 + p], apw[lag * 64 + p]), b = bbl[p * 16 + c2]; s += z.x * b.x - z.y * b.y; }
            km[(lag + 2) * 256 + c * 16 + c2] = (bf16)f2bf(s); }
        if (part == 0) { for (int idx = F.tid; idx < 512; idx += NWAVES * 64) km[idx] = 0;
            bf16* w8 = F.W8 + (size_t)g * T8_ELEMS;
            for (int idx = F.tid; idx < T8_ELEMS; idx += NWAVES * 64) { const int row = idx >> 7, col = idx & 127, p = row >> 1, ri = row & 1, i2 = col >> 4, c2 = col & 15;
                const f2 z = cmul(apw[(7 - i2) * 64 + p], bbl[p * 16 + c2]); w8[idx] = (bf16)f2bf(ri ? z.y : z.x); } }
        if (part == 1) { bf16* g8 = F.G8 + (size_t)g * T8_ELEMS;
            for (int idx = F.tid; idx < T8_ELEMS; idx += NWAVES * 64) { const int row = idx >> 7, col = idx & 127, j2 = row >> 4, c = row & 15, p = col >> 1, ri = col & 1;
                const f2 z = cmul(cl[c * 64 + p], apw[(j2 + 1) * 64 + p]); g8[idx] = (bf16)f2bf(ri ? -z.y : z.x); } }
        if (part == 2) { float* sf = F.SSMF + (size_t)g * SF_STRIDE;
            for (int p = F.tid; p < 64; p += NWAVES * 64) { ((f2*)(sf + SF_A))[p] = apw[1 * 64 + p]; ((f2*)(sf + SF_A8))[p] = apw[8 * 64 + p]; }
            for (int idx = F.tid; idx < 64 * 16; idx += NWAVES * 64) ((f2*)(sf + SF_BB))[idx] = bbl[idx]; }
    }
    __syncthreads();
}

__device__ __forceinline__ void glds16(const void* gsrc, unsigned lds_dst) { unsigned keep;
    asm volatile("s_mov_b32 %0, m0\n\ts_mov_b32 m0, %2\n\ts_nop 0\n\tglobal_load_lds_dwordx4 %1, off\n\ts_mov_b32 m0, %0" : "=&s"(keep) : "v"(gsrc), "s"(lds_dst) : "memory"); }
__device__ __forceinline__ float shfl_up16(float v, int d, int l15) { const float t = __shfl_up(v, d, 16); return l15 >= d ? t : 0.f; }

__device__ __forceinline__ void ssm_unit(Frame& F, int g, int b) {
    const int lane = F.lane, w = F.wave, l15 = lane & 15, kq = lane >> 4;
    const unsigned lds0 = (unsigned)(uintptr_t)(F.lds + RING_OFF);
    LAS const char* L = (LAS const char*)(F.lds + RING_OFF);
    __syncthreads();
    { const v4u* kmg = (const v4u*)(F.KM + (size_t)g * KM_ELEMS); LAS v4u* kml = (LAS v4u*)(F.lds + RING_OFF + L_KM);
      for (int i = F.tid; i < KM_ELEMS / 8; i += NWAVES * 64) kml[i] = kmg[i]; }
    const bf16* usrc = F.U + ((size_t)(b * SEQ) + ((lane >> 1) & 15) * 64 + (lane >> 5)) * D_SSM + g * 16 + (lane & 1) * 8;
#define SSM_SLAB(nt, buf) do { _Pragma("unroll") for (int r_ = 0; r_ < 4; ++r_) { const int q_ = w * 4 + r_; \
        glds16(usrc + ((size_t)(nt) * 1024 + 2 * q_) * D_SSM, (unsigned)__builtin_amdgcn_readfirstlane(lds0 + L_US + (buf) * 32768 + q_ * 1024)); } } while (0)
    SSM_SLAB(0, 0);
    const float* sf = F.SSMF + (size_t)g * SF_STRIDE;
    const int pa = 8 * w + 2 * kq;
    const f2 a8a = ((const f2*)(sf + SF_A8))[pa], a8b = ((const f2*)(sf + SF_A8))[pa + 1];
    const f2* p64 = (const f2*)(sf + SF_P64);
    const f2 pna = p64[l15 * 64 + pa], pnb = p64[l15 * 64 + pa + 1], p16a = p64[16 * 64 + pa], p16b = p64[16 * 64 + pa + 1];
    bf16x8 w8f[4], g8f[4];
#pragma unroll
    for (int ks = 0; ks < 4; ++ks) { w8f[ks] = *(const bf16x8*)(F.W8 + (size_t)g * T8_ELEMS + (16 * w + l15) * 128 + 32 * ks + 8 * kq);
                                     g8f[ks] = *(const bf16x8*)(F.G8 + (size_t)g * T8_ELEMS + (16 * w + l15) * 128 + 32 * ks + 8 * kq); }
    const f32x4 dsk = *(const f32x4*)(F.in[I_DSKIP] + g * 16 + 4 * kq);
    f2 s0a = {0.f, 0.f}, s0b = {0.f, 0.f};
    { const f2 aa = ((const f2*)(sf + SF_A))[pa], ab = ((const f2*)(sf + SF_A))[pa + 1]; const f2* bba = (const f2*)(sf + SF_BB) + pa * 16; const f2* bbb = bba + 16;
      const v4u mu0 = *(const v4u*)(F.UM + l15 * D_SSM + g * 16), mu1 = *(const v4u*)(F.UM + l15 * D_SSM + g * 16 + 8);
      f2 bva[16], bvb[16];
#pragma unroll
      for (int c = 0; c < 16; ++c) { bva[c] = bba[c]; bvb[c] = bbb[c]; }
#pragma unroll
      for (int j = 0; j < NMETA; ++j) {
          const unsigned x0 = __builtin_amdgcn_readlane(mu0.x, j), x1 = __builtin_amdgcn_readlane(mu0.y, j), x2 = __builtin_amdgcn_readlane(mu0.z, j), x3 = __builtin_amdgcn_readlane(mu0.w, j);
          const unsigned x4 = __builtin_amdgcn_readlane(mu1.x, j), x5 = __builtin_amdgcn_readlane(mu1.y, j), x6 = __builtin_amdgcn_readlane(mu1.z, j), x7 = __builtin_amdgcn_readlane(mu1.w, j);
          float u[16];
          u[0] = bf_lo(x0); u[1] = bf_hi(x0); u[2] = bf_lo(x1); u[3] = bf_hi(x1); u[4] = bf_lo(x2); u[5] = bf_hi(x2); u[6] = bf_lo(x3); u[7] = bf_hi(x3);
          u[8] = bf_lo(x4); u[9] = bf_hi(x4); u[10] = bf_lo(x5); u[11] = bf_hi(x5); u[12] = bf_lo(x6); u[13] = bf_hi(x6); u[14] = bf_lo(x7); u[15] = bf_hi(x7);
          f2 ba = {0.f, 0.f}, bb_ = {0.f, 0.f};
#pragma unroll
          for (int c = 0; c < 16; ++c) { ba += bva[c] * u[c]; bb_ += bvb[c] * u[c]; }
          s0a = cmul(aa, s0a) + ba; s0b = cmul(ab, s0b) + bb_; } }
    const int boff = (kq >> 1) * 512 + l15 * 32 + (kq & 1) * 16;
    const int aoff = L_KM + (32 - (kq >> 1) * 16 + l15) * 32 + (kq & 1) * 16;
    const int soff = L_SIN + ((2 * w + (kq >> 1)) * 16 + l15) * 16 + (kq & 1) * 8;
    const int sfrag = L_SIN + (kq * 16 + l15) * 16;
    for (int nt = 0; nt < 4; ++nt) {
        asm volatile("s_waitcnt vmcnt(0) lgkmcnt(0)\n\ts_barrier" ::: "memory");
        if (nt + 1 < 4) SSM_SLAB(nt + 1, (nt + 1) & 1);
        const LAS char* slab = L + L_US + (nt & 1) * 32768;
        f2 ea, eb;
#pragma unroll
        for (int s = 0; s < 8; ++s) { f32x4 acc = {0.f, 0.f, 0.f, 0.f};
            bf16x8 bfs[4];
#pragma unroll
            for (int ks = 0; ks < 4; ++ks) bfs[ks] = *(const LAS bf16x8*)(slab + (8 * s + 2 * ks) * 512 + boff);
#pragma unroll
            for (int ks = 0; ks < 4; ++ks) acc = __builtin_amdgcn_mfma_f32_16x16x32_bf16(w8f[ks], bfs[ks], acc, 0, 0, 0);
            if (s == 0) { ea = (f2){acc[0], acc[1]}; eb = (f2){acc[2], acc[3]}; }
            else { ea = cmul(ea, a8a) + (f2){acc[0], acc[1]}; eb = cmul(eb, a8b) + (f2){acc[2], acc[3]}; } }
#pragma unroll
        for (int d = 1; d < 16; d <<= 1) { const f2 wa = p64[d * 64 + pa], wb = p64[d * 64 + pa + 1];
            const f2 qa = {shfl_up16(ea.x, d, l15), shfl_up16(ea.y, d, l15)}, qb = {shfl_up16(eb.x, d, l15), shfl_up16(eb.y, d, l15)};
            ea += cmul(wa, qa); eb += cmul(wb, qb); }
        f2 sa = cmul(pna, s0a) + (f2){shfl_up16(ea.x, 1, l15), shfl_up16(ea.y, 1, l15)};
        f2 sb = cmul(pnb, s0b) + (f2){shfl_up16(eb.x, 1, l15), shfl_up16(eb.y, 1, l15)};
        { const int src = (lane & 48) | 15;
          const f2 la = {__shfl(ea.x, src), __shfl(ea.y, src)}, lb = {__shfl(eb.x, src), __shfl(eb.y, src)};
          s0a = cmul(p16a, s0a) + la; s0b = cmul(p16b, s0b) + lb; }
#pragma unroll
        for (int s = 0; s < 8; ++s) {
            u2v o; o.x = pk2(sa.x, sa.y); o.y = pk2(sb.x, sb.y);
            *(LAS u2v*)(F.lds + RING_OFF + soff + s * 4096) = o;
            sa = cmul(sa, a8a); sb = cmul(sb, a8b); }
        asm volatile("s_waitcnt lgkmcnt(0)\n\ts_barrier" ::: "memory");
        f32x4 acc[8];
#pragma unroll
        for (int jj = 0; jj < 8; ++jj) acc[jj] = (f32x4){0.f, 0.f, 0.f, 0.f};
#pragma unroll 2
        for (int ks = 0; ks < 32; ++ks) { const int i0 = 2 * ks;
            const bf16x8 bf = *(const LAS bf16x8*)(slab + i0 * 512 + boff);
            bf16x8 af[8];
#pragma unroll
            for (int jj = 0; jj < 8; ++jj) { int d = w + 8 * jj - i0; d = d < -1 ? -1 : d; af[jj] = *(const LAS bf16x8*)(L + aoff + d * 512); }
#pragma unroll
            for (int jj = 0; jj < 8; ++jj) acc[jj] = __builtin_amdgcn_mfma_f32_16x16x32_bf16(af[jj], bf, acc[jj], 0, 0, 0); }
#pragma unroll
        for (int jj = 0; jj < 8; ++jj)
#pragma unroll
            for (int ks = 0; ks < 4; ++ks) { const bf16x8 bf = *(const LAS bf16x8*)(L + sfrag + jj * 4096 + ks * 1024); acc[jj] = __builtin_amdgcn_mfma_f32_16x16x32_bf16(g8f[ks], bf, acc[jj], 0, 0, 0); }
#pragma unroll
        for (int jj = 0; jj < 8; ++jj) { const int j = w + 8 * jj;
            const u2v uu = *(const LAS u2v*)(slab + j * 512 + l15 * 32 + kq * 8);
            const float y0 = acc[jj][0] + dsk[0] * bf_lo(uu.x), y1 = acc[jj][1] + dsk[1] * bf_hi(uu.x), y2 = acc[jj][2] + dsk[2] * bf_lo(uu.y), y3 = acc[jj][3] + dsk[3] * bf_hi(uu.y);
            u2v o; o.x = pk2(gelu_tanh(y0), gelu_tanh(y1)); o.y = pk2(gelu_tanh(y2), gelu_tanh(y3));
            *(u2v*)(F.Gb + ((size_t)(b * SEQ) + nt * 1024 + l15 * 64 + j) * D_SSM + g * 16 + 4 * kq) = o; }
    }
#undef SSM_SLAB
    asm volatile("s_waitcnt vmcnt(0) lgkmcnt(0)" ::: "memory");
    __syncthreads();
}
__device__ __forceinline__ void ssm_phase(Frame& F) {
    for (int un = F.vcu; un < NGRP * BATCH; un += F.G) ssm_unit(F, un >> 2, un & 3);
}
}
#ifndef PROBE_MASK
#define PROBE_MASK 0xff
#endif
#define PROBE_PH(k) (((PROBE_MASK) >> (k)) & 1)
struct Args { const float* in[27]; float* out; unsigned char* ws; int ph_lo, ph_hi, li, pad; };
__global__ void __launch_bounds__(NWAVES * 64, 2) mk_fwd(Args args) {
    extern __shared__ __attribute__((aligned(16))) unsigned char lds[];
    Frame F;
    F.lds = (LAS unsigned char*)lds;
    F.MISC = (volatile LAS unsigned*)(F.lds + MISC_OFF);
    F.tid = threadIdx.x; F.lane = F.tid & 63; F.wave = __builtin_amdgcn_readfirstlane(F.tid >> 6);
    F.G = gridDim.x; { const int bx = blockIdx.x; F.vcu = (F.G % 8 == 0) ? (bx % 8) * (F.G / 8) + bx / 8 : bx; }
    unsigned char* ws = args.ws; F.ws = ws; F.out = args.out;
#pragma unroll
    for (int i = 0; i < 27; ++i) F.in[i] = args.in[i];
    F.ctl = (gu32*)(ws + WS_CTL);
    F.WinT = (bf16*)(ws + WS_WIN); F.WgluT = (bf16*)(ws + WS_WGLU); F.WbraT = (bf16*)(ws + WS_WBRA); F.WbrbT = (bf16*)(ws + WS_WBRB); F.WoT = (bf16*)(ws + WS_WO); F.WguT = (bf16*)(ws + WS_WGU); F.WdnT = (bf16*)(ws + WS_WDN);
    F.HN = (bf16*)(ws + WS_HN); F.TM = (bf16*)(ws + WS_TM); F.U = (bf16*)(ws + WS_U); F.Q = (bf16*)(ws + WS_Q); F.K = (bf16*)(ws + WS_K); F.V = (bf16*)(ws + WS_V); F.GS = (bf16*)(ws + WS_GS); F.GA = (bf16*)(ws + WS_GA);
    F.ACT = (bf16*)(ws + WS_ACT); F.Gb = (bf16*)(ws + WS_G); F.YSSM = (bf16*)(ws + WS_YSSM); F.HNM = (bf16*)(ws + WS_HNM); F.UM = (bf16*)(ws + WS_UM); F.PS = (float*)(ws + WS_PS);
    F.KM = (bf16*)(ws + WS_KM); F.W8 = (bf16*)(ws + WS_W8); F.G8 = (bf16*)(ws + WS_G8); F.SSMF = (float*)(ws + WS_SSMF);
    for (int u = F.tid; u < (LDS_BYTES - LDSCTL_OFF) / 4; u += NWAVES * 64) ((LAS unsigned*)(F.lds + LDSCTL_OFF))[u] = 0u;
    __syncthreads();
    XcdBarrier bar; bar.bar = (unsigned*)(F.ctl + CW_BAR); bar.x = 0; bar.st = nullptr;
    if (N_LAUNCHES == 1) bar = xcd_barrier_post((unsigned*)(F.ctl + CW_BAR), F.MISC + 8);
#define GRID_BAR(seam) do { if (N_LAUNCHES != 1) { if (F.tid == 0) __hip_atomic_store(F.ctl + CW_TMO, 0xBADBA0u | (unsigned)(seam), RLX_AGENT); } else { xcd_barrier(bar); } } while (0)
    const int lo = args.ph_lo, hi = args.ph_hi;
#define IN(k) (lo <= (k) && (k) < hi)
#define BOTH(k) (IN(k) && IN((k) + 1))
    using namespace pg8;
#define PHASE_0() do { const int g3_ = ((int)blockIdx.x >> 3) % 3; if (g3_ == 0) ssm::p0_tables(F); p0_prologue(F, 1); if (g3_ == 1) ssm::p0_tables(F); p0_prologue(F, 2); if (g3_ == 2) ssm::p0_tables(F); } while (0)
#define PHASE_1() do { \
        Gemm g{F.HN, F.WinT, M, D_IN, D}; StaticOrder S; S.init(M, D_IN, F.G, (int)blockIdx.x); \
        EpiInProj E{F.U, F.Q, F.K, F.V, F.GS, F.GA, F.in[I_QG], F.in[I_KG]}; \
        gemm_phase<EpiInProj, StaticOrder, PG8_ALIGN, PG8_SP2>(F.lds + RING_OFF, g, S, E); if (F.tid == 0) (void)__hip_atomic_fetch_add(F.ctl + CW_ARR1, 1u, RLX_AGENT); meta_proj(F); pull_rest_items(F, 1); } while (0)
#define PHASE_2() do { att::attn_phase(F, F.Q); if (((int)blockIdx.x >> 3) & 1) pull_rest_half(F, 1u, 2u, (unsigned)N_REST_NOGU); ssm::ssm_phase(F); pull_rest_until(F, N_REST_NOGU); } while (0)
#define PHASE_3() do { \
        { Gemm g{F.Gb, F.WgluT, M, D_SSM, D_SSM}; StaticOrder S; S.init(M, D_SSM, F.G, (int)blockIdx.x); \
          EpiGlu E{F.Gb, F.in[I_BGLU], F.YSSM}; \
          gemm_phase<EpiGlu, StaticOrder, PG8_ALIGN, PG8_SP2>(F.lds + RING_OFF, g, S, E); } \
        { Gemm g{F.Q, F.WbrbT, M, D, DATT}; StaticOrder S; S.init(M, D, F.G, (int)blockIdx.x); \
          EpiBranch<true> E{F.GA, F.TM}; \
          gemm_phase<EpiBranch<true>, StaticOrder, PG8_ALIGN, PG8_SP2>(F.lds + RING_OFF, g, S, E); } } while (0)
#define PHASE_4() do { Gemm g{F.YSSM, F.WbraT, M, D, D_SSM}; StaticOrder S; S.init(M, D, F.G, (int)blockIdx.x); \
        EpiBranch<false> E{F.GS, F.TM}; \
        gemm_phase<EpiBranch<false>, StaticOrder, PG8_ALIGN, PG8_SP2>(F.lds + RING_OFF, g, S, E); } while (0)
#define PHASE_5() do { if ((((int)blockIdx.x >> 3) & 1) == 0) pull_rest_half(F); \
        { Gemm g{F.TM, F.WoT, M, D, D}; StaticOrder S; S.init(M, D, F.G, (int)blockIdx.x); \
          EpiOut E{F.in[I_X], F.HN, F.PS}; \
          gemm_phase<EpiOut, StaticOrder, PG8_ALIGN, PG8_SP2>(F.lds + RING_OFF, g, S, E); } \
        pull_rest_until(F, N_REST_ALL); } while (0)
#define PHASE_6() do { Gemm g{F.HN, F.WguT, M, 2 * D_FF, D}; TailOrder S; S.init(M, 2 * D_FF, F.G, (int)blockIdx.x); \
        S.q = (unsigned*)(F.ctl + CW_QTAIL); S.slot = (volatile PG8_LAS unsigned*)(F.MISC + 15); S.tail = S.nwg / F.G; \
        EpiGateUp E{F.PS, F.ACT}; \
        gemm_phase<EpiGateUp, TailOrder, PG8_ALIGN, PG8_SP2>(F.lds + RING_OFF, g, S, E); \
        pull_wdown_items(F); } while (0)
#define PHASE_7() do { Gemm g{F.ACT, F.WdnT, M, D, D_FF}; ARowOnceOrder S; S.init(M, D, F.G, (int)blockIdx.x); \
        EpiDown E{F.HN, F.out}; \
        gemm_phase<EpiDown, ARowOnceOrder, PG8_ALIGN, PG8_SP2>(F.lds + RING_OFF, g, S, E); } while (0)
#ifndef PROBE_CLOCK
#define PROBE_CLOCK 0
#endif
#ifndef PROBE_REP
#define PROBE_REP 0
#endif
    if (IN(0)) { PHASE_0(); if (PROBE_REP & 1) { GRID_BAR(0); PHASE_0(); } if (BOTH(0)) GRID_BAR(0); }
    if (IN(1)) { PHASE_1(); if (PROBE_REP & 2) { GRID_BAR(1); PHASE_1(); } if (BOTH(1)) GRID_BAR(1); }
    if (IN(2)) { PHASE_2(); if (PROBE_REP & 256) { ssm::ssm_phase(F); } if (PROBE_REP & 4) { GRID_BAR(2); PHASE_1(); GRID_BAR(2); PHASE_2(); } if (BOTH(2)) GRID_BAR(2); }
    if (IN(3)) { PHASE_3(); if (PROBE_REP & 8) { GRID_BAR(3); PHASE_3(); } if (BOTH(3)) GRID_BAR(3); }
    if (IN(4)) { PHASE_4(); if (PROBE_REP & 16) { GRID_BAR(4); PHASE_3(); GRID_BAR(4); PHASE_4(); } if (BOTH(4)) GRID_BAR(4); }
    if (IN(5) && (PROBE_REP & 2048)) { GRID_BAR(5); GRID_BAR(5); GRID_BAR(5); GRID_BAR(5); GRID_BAR(5); GRID_BAR(5); GRID_BAR(5); GRID_BAR(5); }
    if (IN(5) && (PROBE_REP & 1024)) { Gemm g{F.TM, F.WoT, M, D, D}; StaticOrder S; S.init(M, D, F.G, (int)blockIdx.x);
        EpiOut E{F.in[I_X], F.HN, F.PS};
        gemm_phase<EpiOut, StaticOrder, PG8_ALIGN, PG8_SP2, true>(F.lds + RING_OFF, g, S, E); GRID_BAR(5); }
    if (IN(5)) { PHASE_5(); if (PROBE_REP & 32) { GRID_BAR(5); PHASE_5(); } if (BOTH(5)) GRID_BAR(5); }
#if PROBE_CLOCK
    long long pc0_ = 0; unsigned long long pr0_ = 0;
    if (IN(6)) { pc0_ = clock64(); pr0_ = __builtin_amdgcn_s_memrealtime(); }
#endif
    if (IN(6)) { PHASE_6(); if (PROBE_REP & 64) { GRID_BAR(6); PHASE_5(); GRID_BAR(6); PHASE_6(); } if (BOTH(6)) GRID_BAR(6); }
#if PROBE_CLOCK
    if (IN(6) && blockIdx.x == 0 && F.tid == 0) { const long long dc_ = clock64() - pc0_; const unsigned long long dr_ = __builtin_amdgcn_s_memrealtime() - pr0_;
        F.ctl[CW_CODE + 8] = (unsigned)((double)dc_ * 100.0 / (double)dr_); }
#endif
    if (IN(7)) { PHASE_7(); if (PROBE_REP & 128) { GRID_BAR(7); PHASE_5(); GRID_BAR(7); PHASE_6(); GRID_BAR(7); PHASE_7(); } }
#if PROBE_CLOCK
    if (IN(7)) { GRID_BAR(7); if (blockIdx.x == 0 && F.tid == 0) { const unsigned mhz_ = __hip_atomic_load(F.ctl + CW_CODE + 8, RLX_AGENT); F.out[0] += (float)((int)mhz_ - PROBE_CLOCK); } }
#endif
#undef IN
#undef BOTH
}

extern "C" void kernel_launch(void* const* d_in, const int* in_sizes, int n_in, void* d_out, int out_size, void* d_ws, size_t ws_size, hipStream_t stream) {
    static int grid = 0;
    if (grid == 0) {
        if (n_in != 27 || in_sizes[0] != M * D || out_size != M * D || ws_size < WS_END) { fprintf(stderr, "kernel_launch: built for 27 inputs, x and out of %d floats, >= %zu bytes of workspace; got n_in %d, in0 %d, out %d, ws %zu; nothing launched\n", M * D, (size_t)WS_END, n_in, n_in > 0 ? in_sizes[0] : -1, out_size, ws_size); grid = -1; return; }
        int dev = 0, cus = 0, per_cu = 0;
        if (hipGetDevice(&dev) != hipSuccess || hipDeviceGetAttribute(&cus, hipDeviceAttributeMultiprocessorCount, dev) != hipSuccess) { fprintf(stderr, "kernel_launch: hipGetDevice / hipDeviceGetAttribute failed; nothing launched\n"); grid = -1; return; }
        if (hipFuncSetAttribute((const void*)mk_fwd, hipFuncAttributeMaxDynamicSharedMemorySize, LDS_BYTES) != hipSuccess) { fprintf(stderr, "kernel_launch: hipFuncSetAttribute failed; nothing launched\n"); grid = -1; return; }
        if (hipOccupancyMaxActiveBlocksPerMultiprocessor(&per_cu, (const void*)mk_fwd, NWAVES * 64, LDS_BYTES) != hipSuccess || per_cu < 1)
            fprintf(stderr, "kernel_launch: note: the occupancy query reports %d workgroups per CU\n", per_cu);
        (void)hipGetLastError();
        grid = cus;
    }
    if (grid < 0) return;
    if (hipMemsetAsync((char*)d_ws + WS_CTL, 0, CTL_ZERO_BYTES, stream) != hipSuccess) { fprintf(stderr, "kernel_launch: hipMemsetAsync of the control words failed; nothing launched\n"); return; }
    Args a{};
    for (int i = 0; i < 27; ++i) a.in[i] = (const float*)d_in[i];
    a.out = (float*)d_out; a.ws = (unsigned char*)d_ws;
    for (int li = 0; li < N_LAUNCHES; ++li) {
        a.ph_lo = (N_LAUNCHES == 1) ? 0 : li; a.ph_hi = (N_LAUNCHES == 1) ? N_PHASES : li + 1; a.li = li;
        hipLaunchKernelGGL(mk_fwd, dim3(grid), dim3(NWAVES * 64), LDS_BYTES, stream, a);
        const hipError_t le = hipPeekAtLastError();
        if (le != hipSuccess) { fprintf(stderr, "kernel_launch: launch %d failed: %s (grid %d x %d threads, %d B LDS)\n", li, hipGetErrorName(le), grid, NWAVES * 64, LDS_BYTES); break; }
    }
}
```

```cpp
#include <hip/hip_runtime.h>
#include <hip/hip_bf16.h>
#include <cstdio>
#include <cstdint>
#include <cmath>
namespace pg8 {
#define PG8_LAS __attribute__((address_space(3)))
typedef unsigned short bf16_t;
typedef short bf16x8 __attribute__((ext_vector_type(8)));
typedef float f32x4 __attribute__((ext_vector_type(4)));
typedef unsigned u32x4 __attribute__((ext_vector_type(4)));
constexpr int BM = 256, BK = 64, HALF = 128, HTB = HALF * BK * 2  , STAGE_BYTES = 8 * HTB, NXCD = 8, WGM = 8;

__host__ __device__ __forceinline__ int lds_byte(int r, int c) { const int st = (r >> 4) * 2 + (c >> 5), rr = r & 15, cc = c & 31, ob = rr * 64 + cc * 2; return st * 1024 + (ob ^ (((ob >> 9) & 1) << 5)); }
__host__ __device__ __forceinline__ void stage_rc(int b, int& R, int& C) { const int st = b / 1024, sb = b % 1024, swz = sb ^ (((sb >> 9) & 1) << 5); R = (st >> 1) * 16 + swz / 64; C = (st & 1) * 32 + (swz % 64) / 2; }
__host__ __device__ __forceinline__ int perm32(int rho) { const int n = rho >> 4, i = rho & 15; return 8 * (i >> 2) + 4 * n + (i & 3); }

struct Unit { int pm, pn; };
struct Gemm { const bf16_t* A; const bf16_t* Bt; int M, N, K; };

struct StaticOrder {
    int nM, nN, nwg, G, c;
    __host__ __device__ void init(int M, int N, int G_, int c_) { nM = M / BM; nN = N / BM; nwg = nM * nN; G = G_; c = c_; }
    __host__ __device__ bool next(int i, Unit& u) const {
        const long L = (long)i * G + c; if (L >= nwg) return false;
        int wgid = (int)L; { const int q = nwg / NXCD, r = nwg % NXCD, xcd = wgid % NXCD, off = wgid / NXCD; wgid = (xcd < r ? xcd * (q + 1) : r * (q + 1) + (xcd - r) * q) + off; }
        const int nig = WGM * nN, gid = wgid / nig, fm = gid * WGM, gsz = (nM - fm) < WGM ? (nM - fm) : WGM;
        u.pm = fm + ((wgid % nig) % gsz); u.pn = (wgid % nig) / gsz; return true;
    }
    __device__ __forceinline__ void a_ready(const Unit&) const {}
    __device__ __forceinline__ void done(const Unit&) const {}
};
struct ARowOnceOrder {
    int G, c;
    __host__ __device__ void init(int, int, int G_, int c_) { G = G_; c = c_; }
    __host__ __device__ bool next(int i, Unit& u) const {
        if (G != 256 || i >= 4) { if (G == 256) return false; const long L = (long)i * G + c; if (L >= 64 * 16) return false; u.pm = (int)(L >> 4); u.pn = (int)(L & 15); return true; }
        const int x = c & 7, j = c >> 3;
        u.pm = 16 * i + 4 * (x >> 1) + (j >> 3); u.pn = 8 * (x & 1) + (j & 7); return true;
    }
    __device__ __forceinline__ void a_ready(const Unit&) const {}
    __device__ __forceinline__ void done(const Unit&) const {}
};
struct TailOrder : StaticOrder {
    unsigned* q; volatile PG8_LAS unsigned* slot; int tail;
    __device__ __forceinline__ bool next(int i, Unit& u) const {
        if (i < tail) return StaticOrder::next(i, u);
        if (i > tail) return false;
        if (threadIdx.x == 0) { const unsigned k = __hip_atomic_fetch_add(q, 1u, __ATOMIC_RELAXED, __HIP_MEMORY_SCOPE_AGENT); *slot = k; }
        asm volatile("s_waitcnt lgkmcnt(0)" ::: "memory"); __builtin_amdgcn_s_barrier(); asm volatile("" ::: "memory");
        const long L = (long)tail * G + (long)*slot; if (L >= nwg) return false;
        int wgid = (int)L; { const int qq = nwg / NXCD, r = nwg % NXCD, xcd = wgid % NXCD, off = wgid / NXCD; wgid = (xcd < r ? xcd * (qq + 1) : r * (qq + 1) + (xcd - r) * qq) + off; }
        const int nig = WGM * nN, gid = wgid / nig, fm = gid * WGM, gsz = (nM - fm) < WGM ? (nM - fm) : WGM;
        u.pm = fm + ((wgid % nig) % gsz); u.pn = (wgid % nig) / gsz; return true;
    }
};

__device__ __forceinline__ unsigned cvt_pk_bf16(float lo, float hi) { unsigned r; asm volatile("v_cvt_pk_bf16_f32 %0, %1, %2" : "=v"(r) : "v"(lo), "v"(hi)); return r; }
typedef float f32x2 __attribute__((ext_vector_type(2)));
constexpr float kEps = 1e-6f;
constexpr float kQScale = 0.125f * 1.4426950408889634f;
__device__ __forceinline__ float sigm(float x) { return __builtin_amdgcn_rcpf(1.0f + __builtin_amdgcn_exp2f(-1.4426950408889634f * x)); }
__device__ __forceinline__ void unpack8(const u32x4 w, float (&f)[8]) {
    f[0] = __uint_as_float(w.x << 16); f[1] = __uint_as_float(w.x & 0xffff0000u); f[2] = __uint_as_float(w.y << 16); f[3] = __uint_as_float(w.y & 0xffff0000u);
    f[4] = __uint_as_float(w.z << 16); f[5] = __uint_as_float(w.z & 0xffff0000u); f[6] = __uint_as_float(w.w << 16); f[7] = __uint_as_float(w.w & 0xffff0000u);
}
__device__ __forceinline__ u32x4 pack8(const f32x4 a, const f32x4 b) { u32x4 w; w.x = cvt_pk_bf16(a[0], a[1]); w.y = cvt_pk_bf16(a[2], a[3]); w.z = cvt_pk_bf16(b[0], b[1]); w.w = cvt_pk_bf16(b[2], b[3]); return w; }
#define EPI_FENCE() asm volatile("" ::: "memory")

struct EpiInProj {
    static constexpr bool PERM = true, AFTER_DRAIN = false;
    bf16_t *U, *Q, *K, *V, *GS, *GA; const float *qg, *kg;
    __device__ __forceinline__ void operator()(const f32x4 (&acc)[2][2][4][2], const Unit& u, int wr, int wc, int fr, int fq) const {
        const int pn = u.pn; const int row0 = u.pm * BM + wr * 64 + fr;
        const int kvoff = 64 * (u.pm / 16 + 1);
        if (pn >= 4 && pn < 20) {
            const bool isq = pn < 12; const int tile = isq ? pn - 4 : pn - 12;
            bf16_t* base = isq ? Q : K; const float* g = isq ? qg : kg; const float sc = isq ? kQScale : 1.0f; const int roff = isq ? 0 : kvoff;
            f32x4 gv[2][2];
#pragma unroll
            for (int bj = 0; bj < 2; ++bj)
#pragma unroll
                for (int n = 0; n < 2; ++n) gv[bj][n] = *(const f32x4*)(g + 32 * bj + 8 * fq + 4 * n) * sc;
#pragma unroll
            for (int ai = 0; ai < 2; ++ai)
#pragma unroll
                for (int m = 0; m < 4; ++m) {
                    float ss = 0.f;
#pragma unroll
                    for (int bj = 0; bj < 2; ++bj)
#pragma unroll
                        for (int n = 0; n < 2; ++n) { const f32x4 x = acc[ai][bj][m][n]; ss += (x[0] * x[0] + x[1] * x[1]) + (x[2] * x[2] + x[3] * x[3]); }
                    ss += __shfl_xor(ss, 16); ss += __shfl_xor(ss, 32);
                    const float rstd = __builtin_amdgcn_rsqf(ss * (1.0f / 64.0f) + kEps);
                    bf16_t* rowp = base + (size_t)(row0 + ai * HALF + m * 16 + roff) * 2048 + tile * 256 + 64 * wc + 8 * fq;
#pragma unroll
                    for (int bj = 0; bj < 2; ++bj) *(u32x4*)(rowp + 32 * bj) = pack8(acc[ai][bj][m][0] * rstd * gv[bj][0], acc[ai][bj][m][1] * rstd * gv[bj][1]);
                }
            return;
        }
        bf16_t* base; int ldc, colt, roff = 0; bool sg = false;
        if (pn < 4) { base = U; ldc = 1024; colt = pn * BM; }
        else if (pn < 28) { base = V; ldc = 2048; colt = (pn - 20) * BM; roff = kvoff; }
        else if (pn < 44) { base = GS; ldc = 4096; colt = (pn - 28) * BM; sg = true; }
        else { base = GA; ldc = 4096; colt = (pn - 44) * BM; sg = true; }
        const int col0 = colt + wc * 32 + 8 * fq;
#pragma unroll
        for (int ai = 0; ai < 2; ++ai)
#pragma unroll
            for (int m = 0; m < 4; ++m) { bf16_t* rowp = base + (size_t)(row0 + ai * HALF + m * 16 + roff) * ldc + col0;
#pragma unroll
                for (int bj = 0; bj < 2; ++bj) { f32x4 v0 = acc[ai][bj][m][0], v1 = acc[ai][bj][m][1];
                    if (sg) {
#pragma unroll
                        for (int e = 0; e < 4; ++e) { v0[e] = sigm(v0[e]); v1[e] = sigm(v1[e]); } }
                    *(u32x4*)(rowp + bj * HALF) = pack8(v0, v1); } }
    }
};
struct EpiGlu {
    static constexpr bool PERM = true, AFTER_DRAIN = false;
    const bf16_t* G; const float* bias; bf16_t* Y;
    __device__ __forceinline__ void operator()(const f32x4 (&acc)[2][2][4][2], const Unit& u, int wr, int wc, int fr, int fq) const {
        const int row0 = u.pm * BM + wr * 64 + fr, col0 = u.pn * BM + wc * 32 + 8 * fq;
        f32x4 bv[2][2];
#pragma unroll
        for (int bj = 0; bj < 2; ++bj)
#pragma unroll
            for (int n = 0; n < 2; ++n) bv[bj][n] = *(const f32x4*)(bias + col0 + bj * HALF + 4 * n);
#pragma unroll
        for (int ai = 0; ai < 2; ++ai)
#pragma unroll
            for (int m = 0; m < 4; ++m) { const size_t off = (size_t)(row0 + ai * HALF + m * 16) * 1024 + col0;
#pragma unroll
                for (int bj = 0; bj < 2; ++bj) { float g[8]; unpack8(*(const u32x4*)(G + off + bj * HALF), g);
                    f32x4 v0 = acc[ai][bj][m][0] + bv[bj][0], v1 = acc[ai][bj][m][1] + bv[bj][1];
#pragma unroll
                    for (int e = 0; e < 4; ++e) { v0[e] = g[e] * sigm(v0[e]); v1[e] = g[4 + e] * sigm(v1[e]); }
                    *(u32x4*)(Y + off + bj * HALF) = pack8(v0, v1); }
                EPI_FENCE(); }
    }
};
template <bool FIRST> struct EpiBranch {
    static constexpr bool PERM = true, AFTER_DRAIN = false;
    const bf16_t* GATE; bf16_t* T;
    __device__ __forceinline__ void operator()(const f32x4 (&acc)[2][2][4][2], const Unit& u, int wr, int wc, int fr, int fq) const {
        const int row0 = u.pm * BM + wr * 64 + fr, col0 = u.pn * BM + wc * 32 + 8 * fq;
#pragma unroll
        for (int ai = 0; ai < 2; ++ai)
#pragma unroll
            for (int m = 0; m < 4; ++m) { const size_t off = (size_t)(row0 + ai * HALF + m * 16) * 4096 + col0;
#pragma unroll
                for (int bj = 0; bj < 2; ++bj) { float g[8]; unpack8(*(const u32x4*)(GATE + off + bj * HALF), g);
                    f32x4 v0 = acc[ai][bj][m][0], v1 = acc[ai][bj][m][1];
                    if (FIRST) {
#pragma unroll
                        for (int e = 0; e < 4; ++e) { v0[e] *= g[e]; v1[e] *= g[4 + e]; }
                    } else { float t[8]; unpack8(*(const u32x4*)(T + off + bj * HALF), t);
#pragma unroll
                        for (int e = 0; e < 4; ++e) { v0[e] = t[e] + v0[e] * g[e]; v1[e] = t[4 + e] + v1[e] * g[4 + e]; } }
                    *(u32x4*)(T + off + bj * HALF) = pack8(v0, v1); }
                EPI_FENCE(); }
    }
};
struct EpiOut {
    static constexpr bool PERM = true, AFTER_DRAIN = false;
    const float* X; bf16_t* HB; float* PS;
    __device__ __forceinline__ void operator()(const f32x4 (&acc)[2][2][4][2], const Unit& u, int wr, int wc, int fr, int fq) const {
        const int row0 = u.pm * BM + wr * 64 + fr, col0 = u.pn * BM + wc * 32 + 8 * fq;
#pragma unroll
        for (int ai = 0; ai < 2; ++ai)
#pragma unroll
            for (int m = 0; m < 4; ++m) { const int row = row0 + ai * HALF + m * 16; const size_t off = (size_t)row * 4096 + col0; float ss = 0.f;
#pragma unroll
                for (int bj = 0; bj < 2; ++bj) { const f32x4 x0 = *(const f32x4*)(X + off + bj * HALF), x1 = *(const f32x4*)(X + off + bj * HALF + 4);
                    const f32x4 v0 = acc[ai][bj][m][0] + x0, v1 = acc[ai][bj][m][1] + x1;
                    ss += (v0[0] * v0[0] + v0[1] * v0[1]) + (v0[2] * v0[2] + v0[3] * v0[3]) + (v1[0] * v1[0] + v1[1] * v1[1]) + (v1[2] * v1[2] + v1[3] * v1[3]);
                    *(u32x4*)(HB + off + bj * HALF) = pack8(v0, v1); }
                ss += __shfl_xor(ss, 16); ss += __shfl_xor(ss, 32);
                if (fq == 0) PS[(size_t)row * 64 + u.pn * 4 + wc] = ss;
                EPI_FENCE(); }
    }
};
struct EpiGateUp {
    static constexpr bool PERM = true, AFTER_DRAIN = false;
    const float* PS; bf16_t* ACT;
    __device__ __forceinline__ void operator()(const f32x4 (&acc)[2][2][4][2], const Unit& u, int wr, int wc, int fr, int fq) const {
        const int row0 = u.pm * BM + wr * 64 + fr, col0 = u.pn * HALF + wc * 32 + 8 * fq;
#pragma unroll
        for (int ai = 0; ai < 2; ++ai)
#pragma unroll
            for (int m = 0; m < 4; ++m) { const int row = row0 + ai * HALF + m * 16;
                const f32x4* ps = (const f32x4*)(PS + (size_t)row * 64 + fq * 16);
                const f32x4 p0 = ps[0], p1 = ps[1], p2 = ps[2], p3 = ps[3];
                float ss = ((p0[0] + p0[1]) + (p0[2] + p0[3])) + ((p1[0] + p1[1]) + (p1[2] + p1[3])) + ((p2[0] + p2[1]) + (p2[2] + p2[3])) + ((p3[0] + p3[1]) + (p3[2] + p3[3]));
                ss += __shfl_xor(ss, 16); ss += __shfl_xor(ss, 32);
                const float r = __builtin_amdgcn_rsqf(ss * (1.0f / 4096.0f) + kEps);
                f32x4 v0, v1;
#pragma unroll
                for (int e = 0; e < 4; ++e) { const float g0 = acc[ai][0][m][0][e] * r, u0 = acc[ai][1][m][0][e] * r, g1 = acc[ai][0][m][1][e] * r, u1 = acc[ai][1][m][1][e] * r;
                    v0[e] = g0 * sigm(g0) * u0; v1[e] = g1 * sigm(g1) * u1; }
                *(u32x4*)(ACT + (size_t)row * 11008 + col0) = pack8(v0, v1);
                EPI_FENCE(); }
    }
};
struct EpiDown {
    static constexpr bool PERM = true, AFTER_DRAIN = false;
    const bf16_t* HB; float* OUT;
    __device__ __forceinline__ void operator()(const f32x4 (&acc)[2][2][4][2], const Unit& u, int wr, int wc, int fr, int fq) const {
        const int row0 = u.pm * BM + wr * 64 + fr, col0 = u.pn * BM + wc * 32 + 8 * fq;
#pragma unroll
        for (int ai = 0; ai < 2; ++ai)
#pragma unroll
            for (int m = 0; m < 4; ++m) { const size_t off = (size_t)(row0 + ai * HALF + m * 16) * 4096 + col0;
#pragma unroll
                for (int bj = 0; bj < 2; ++bj) { float h[8]; unpack8(*(const u32x4*)(HB + off + bj * HALF), h); f32x4* p = (f32x4*)(OUT + off + bj * HALF);
                    p[0] = acc[ai][bj][m][0] + (f32x4){h[0], h[1], h[2], h[3]}; p[1] = acc[ai][bj][m][1] + (f32x4){h[4], h[5], h[6], h[7]}; }
                EPI_FENCE(); }
    }
};
template <class Epi, class Sched, bool ALIGN_EPI = false, bool SP2 = false, bool PLOCAL = false>
__device__ __forceinline__ void gemm_phase(PG8_LAS unsigned char* lds, const Gemm g, const Sched& S, const Epi& E) {
    const int tid = threadIdx.x, wid = __builtin_amdgcn_readfirstlane(tid >> 6), lane = tid & 63, wr = wid >> 2, wc = wid & 3, fr = lane & 15, fq = lane >> 4;
    const int K = g.K, nt = K / BK;
    unsigned voffA[2], voffB[2];
#pragma unroll
    for (int i = 0; i < 2; ++i) { int R, C; stage_rc(tid * 16 + i * 8192, R, C); const int Rb = Epi::PERM ? ((R & ~31) + perm32(R & 31)) : R;
        voffA[i] = (unsigned)(R * K + C) * 2u; voffB[i] = (unsigned)(Rb * K + C) * 2u; }
    const size_t kstep = (size_t)(BK * 2);
    const size_t hstep = (size_t)HALF * K * 2;
    const size_t tstep = 2 * hstep;
    const unsigned ldsw = (unsigned)wid * 1024u;
    const int aoff = lds_byte(wr * 64 + fr, fq * 8), boff = lds_byte(wc * 32 + fr, fq * 8);
#define PG8_SA(b, h) (((b) * 2 + (h)) * HTB)
#define PG8_SB(b, h) ((4 + (b) * 2 + (h)) * HTB)
#define PG8_STAGE(bufoff, gbase, voff) do { _Pragma("unroll") for (int _i = 0; _i < 2; ++_i) \
        __builtin_amdgcn_global_load_lds((const unsigned*)((const char*)(gbase) + (voff)[_i]), (PG8_LAS unsigned*)(lds + (bufoff) + ldsw + _i * 8192), 16, 0, 0); } while (0)
#define PG8_LDA(dst, b, h) do { _Pragma("unroll") for (int m = 0; m < 4; ++m) _Pragma("unroll") for (int k = 0; k < 2; ++k) dst[m][k] = *(const PG8_LAS bf16x8*)(lds + PG8_SA(b, h) + aoff + m * 2048 + k * 1024); } while (0)
#define PG8_LDB(dst, b, h) do { _Pragma("unroll") for (int n = 0; n < 2; ++n) _Pragma("unroll") for (int k = 0; k < 2; ++k) dst[n][k] = *(const PG8_LAS bf16x8*)(lds + PG8_SB(b, h) + boff + n * 2048 + k * 1024); } while (0)
#define PG8_MMA(ai, bj, At, Bt) do { __builtin_amdgcn_s_setprio(1); _Pragma("unroll") for (int m = 0; m < 4; ++m) _Pragma("unroll") for (int n = 0; n < 2; ++n) _Pragma("unroll") for (int k = 0; k < 2; ++k) \
        acc[ai][bj][m][n] = __builtin_amdgcn_mfma_f32_16x16x32_bf16(Bt[n][k], At[m][k], acc[ai][bj][m][n], 0, 0, 0); __builtin_amdgcn_s_setprio(0); } while (0)
#define PG8_WAIT_V(n) asm volatile("s_waitcnt vmcnt(" #n ")" ::: "memory")
#define PG8_WAIT_L(n) asm volatile("s_waitcnt lgkmcnt(" #n ")" ::: "memory")
#define PG8_BAR __builtin_amdgcn_s_barrier()
#define PG8_SCHED __builtin_amdgcn_sched_barrier(0)
    Unit cur, nxt; int ui = 0;
    if (!S.next(0, cur)) return;
    f32x4 acc[2][2][4][2];
#pragma unroll
    for (int a = 0; a < 2; ++a)
#pragma unroll
        for (int b = 0; b < 2; ++b)
#pragma unroll
            for (int m = 0; m < 4; ++m)
#pragma unroll
                for (int n = 0; n < 2; ++n) acc[a][b][m][n] = (f32x4){0.f, 0.f, 0.f, 0.f};
    bf16x8 At[4][2], B0[2][2], B1[2][2];
    const char* cA = (const char*)g.A + (size_t)(PLOCAL ? 0 : cur.pm) * tstep; const char* cB = (const char*)g.Bt + (size_t)(PLOCAL ? 0 : cur.pn) * tstep;
    S.a_ready(cur);
    if constexpr (SP2) {
        PG8_STAGE(PG8_SB(0, 0), cB, voffB); PG8_STAGE(PG8_SB(0, 1), cB + hstep, voffB); PG8_STAGE(PG8_SA(0, 0), cA, voffA); PG8_STAGE(PG8_SA(0, 1), cA + hstep, voffA);
        if (wr == 1) PG8_BAR;
        PG8_WAIT_V(2); PG8_BAR;
        PG8_STAGE(PG8_SB(1, 0), cB + kstep, voffB); PG8_STAGE(PG8_SA(1, 0), cA + kstep, voffA); PG8_STAGE(PG8_SB(1, 1), cB + hstep + kstep, voffB);
        PG8_WAIT_V(6); PG8_BAR;
    } else {
        PG8_STAGE(PG8_SB(0, 0), cB, voffB); PG8_STAGE(PG8_SA(0, 0), cA, voffA); PG8_STAGE(PG8_SB(0, 1), cB + hstep, voffB); PG8_STAGE(PG8_SA(0, 1), cA + hstep, voffA);
        if (wr == 1) PG8_BAR;
        PG8_WAIT_V(4); PG8_BAR;
        PG8_STAGE(PG8_SB(1, 0), cB + kstep, voffB); PG8_STAGE(PG8_SA(1, 0), cA + kstep, voffA); PG8_STAGE(PG8_SB(1, 1), cB + hstep + kstep, voffB);
        PG8_WAIT_V(6); PG8_BAR;
    }
    for (;;) {
        const bool has_next = S.next(ui + 1, nxt);
        const char* nA = has_next ? (const char*)g.A + (size_t)(PLOCAL ? 0 : nxt.pm) * tstep : cA; const char* nB = has_next ? (const char*)g.Bt + (size_t)(PLOCAL ? 0 : nxt.pn) * tstep : cB;
        for (int t = 0; t < nt; t += 2) {
            const bool last = (t == nt - 2);
            const char* a1 = cA + (size_t)(t + 1) * kstep;
            const char* a2 = last ? nA : cA + (size_t)(t + 2) * kstep; const char* b2 = last ? nB : cB + (size_t)(t + 2) * kstep;
            const char* a3 = a2 + kstep; const char* b3 = b2 + kstep;
            if (last && has_next) S.a_ready(nxt);
            if constexpr (SP2) {
            PG8_LDB(B0, 0, 0); PG8_LDB(B1, 0, 1); PG8_SCHED; PG8_LDA(At, 0, 0); PG8_STAGE(PG8_SA(1, 1), a1 + hstep, voffA);
            PG8_WAIT_V(8); PG8_WAIT_L(0); PG8_BAR; PG8_MMA(0, 0, At, B0); PG8_MMA(0, 1, At, B1); PG8_BAR; PG8_SCHED;
            PG8_LDA(At, 0, 1); PG8_STAGE(PG8_SB(0, 0), b2, voffB); PG8_STAGE(PG8_SB(0, 1), b2 + hstep, voffB); PG8_STAGE(PG8_SA(0, 0), a2, voffA);
            PG8_WAIT_V(8); PG8_WAIT_L(0); PG8_BAR; PG8_MMA(1, 0, At, B0); PG8_MMA(1, 1, At, B1); PG8_BAR; PG8_SCHED;
            PG8_LDB(B0, 1, 0); PG8_LDB(B1, 1, 1); PG8_SCHED; PG8_LDA(At, 1, 0); PG8_STAGE(PG8_SA(0, 1), a2 + hstep, voffA);
            PG8_WAIT_V(8); PG8_WAIT_L(0); PG8_BAR; PG8_MMA(0, 0, At, B0); PG8_MMA(0, 1, At, B1); PG8_BAR; PG8_SCHED;
            PG8_LDA(At, 1, 1); PG8_STAGE(PG8_SB(1, 0), b3, voffB); PG8_STAGE(PG8_SB(1, 1), b3 + hstep, voffB); PG8_STAGE(PG8_SA(1, 0), a3, voffA);
            PG8_WAIT_V(8); PG8_WAIT_L(0); PG8_BAR; PG8_MMA(1, 0, At, B0); PG8_MMA(1, 1, At, B1); PG8_BAR; PG8_SCHED;
            } else {
            PG8_LDB(B0, 0, 0); PG8_SCHED; PG8_LDA(At, 0, 0); PG8_STAGE(PG8_SA(1, 1), a1 + hstep, voffA);
            PG8_WAIT_L(8); PG8_BAR; PG8_WAIT_L(0); PG8_MMA(0, 0, At, B0); PG8_BAR; PG8_SCHED;
            PG8_LDB(B1, 0, 1); PG8_STAGE(PG8_SB(0, 0), b2, voffB);
            PG8_BAR; PG8_WAIT_L(0); PG8_MMA(0, 1, At, B1); PG8_BAR;
            PG8_LDA(At, 0, 1); PG8_STAGE(PG8_SA(0, 0), a2, voffA);
            PG8_BAR; PG8_WAIT_L(0); PG8_MMA(1, 0, At, B0); PG8_BAR; PG8_SCHED;
            PG8_STAGE(PG8_SB(0, 1), b2 + hstep, voffB);
            PG8_WAIT_V(6); PG8_BAR; PG8_MMA(1, 1, At, B1); PG8_BAR;
            PG8_LDB(B0, 1, 0); PG8_SCHED; PG8_LDA(At, 1, 0); PG8_STAGE(PG8_SA(0, 1), a2 + hstep, voffA);
            PG8_WAIT_L(8); PG8_BAR; PG8_WAIT_L(0); PG8_MMA(0, 0, At, B0); PG8_BAR; PG8_SCHED;
            PG8_LDB(B1, 1, 1); PG8_STAGE(PG8_SB(1, 0), b3, voffB);
            PG8_BAR; PG8_WAIT_L(0); PG8_MMA(0, 1, At, B1); PG8_BAR;
            PG8_LDA(At, 1, 1); PG8_STAGE(PG8_SA(1, 0), a3, voffA);
            PG8_BAR; PG8_WAIT_L(0); PG8_MMA(1, 0, At, B0); PG8_BAR; PG8_SCHED;
            PG8_STAGE(PG8_SB(1, 1), b3 + hstep, voffB);
            PG8_WAIT_V(6); PG8_BAR; PG8_MMA(1, 1, At, B1); PG8_BAR;
            }
        }
        if constexpr (ALIGN_EPI) { if (wr == 0) PG8_BAR; }
        if constexpr (!Epi::AFTER_DRAIN) { E(acc, cur, wr, wc, fr, fq); S.done(cur); }
        if (!has_next) break;
#pragma unroll
        for (int a = 0; a < 2; ++a)
#pragma unroll
            for (int b = 0; b < 2; ++b)
#pragma unroll
                for (int m = 0; m < 4; ++m)
#pragma unroll
                    for (int n = 0; n < 2; ++n) acc[a][b][m][n] = (f32x4){0.f, 0.f, 0.f, 0.f};
        cur = nxt; cA = nA; cB = nB; ++ui;
        if constexpr (ALIGN_EPI) { if (wr == 1) PG8_BAR; }
    }
    PG8_WAIT_V(0);
    if constexpr (!ALIGN_EPI) { if (wr == 0) PG8_BAR; }
    PG8_BAR;
    if constexpr (Epi::AFTER_DRAIN) { E.fused(acc, cur, wr, wc, fr, fq, lds, wid, lane); S.done(cur); }
#undef PG8_SA
#undef PG8_SB
#undef PG8_STAGE
#undef PG8_LDA
#undef PG8_LDB
#undef PG8_MMA
#undef PG8_WAIT_V
#undef PG8_WAIT_L
#undef PG8_BAR
#undef PG8_SCHED
}
}

#ifndef PG8_SP2
#define PG8_SP2 true
#endif
#ifndef PG8_ALIGN
#define PG8_ALIGN true
#endif
constexpr int NWAVES = 8;
#ifndef MK_N_LAUNCHES
#define MK_N_LAUNCHES 1
#endif
constexpr int N_PHASES = 8;
constexpr int N_LAUNCHES = MK_N_LAUNCHES;

constexpr int BATCH = 4, SEQ = 4096, D = 4096, NMETA = 16;
constexpr int M = BATCH * SEQ;
constexpr int D_SSM = 1024, NGRP = 64, SGRP = 16, NSTATE = 64;
constexpr int NH = 16, HD = 64, VD = 128, QKW = 2048, DATT = 2048;
constexpr int D_IN = 15360, D_FF = 11008;
constexpr int KVROWS = SEQ + 64;
constexpr float EPS = 1e-6f;
constexpr float LAMBDA_INIT = 0.2f;
constexpr float LOG2E = 1.4426950408889634f;

constexpr size_t MiB = 1u << 20;
constexpr size_t WS_CTL = 0, CTL_ZERO_BYTES = 1 * MiB;
constexpr size_t WS_WIN = 2 * MiB, WS_WGLU = 122 * MiB, WS_WBRA = 124 * MiB, WS_WBRB = 132 * MiB, WS_WO = 148 * MiB, WS_WGU = 180 * MiB, WS_WDN = 352 * MiB;
constexpr size_t WS_HN = 438 * MiB;
constexpr size_t WS_TM = 566 * MiB;
constexpr size_t WS_U = 694 * MiB, WS_Q = 726 * MiB, WS_K = 790 * MiB, WS_V = 855 * MiB, WS_GS = 920 * MiB, WS_GA = 1048 * MiB;
constexpr size_t WS_ACT = 694 * MiB;
constexpr size_t WS_G = 1176 * MiB, WS_YSSM = 1208 * MiB;
constexpr size_t WS_PS = 1240 * MiB;
constexpr size_t WS_HNM = 1244 * MiB, WS_UM = 1245 * MiB;
constexpr size_t WS_KM = 1246 * MiB, WS_W8 = 1249 * MiB, WS_G8 = 1251 * MiB, WS_SSMF = 1253 * MiB;
constexpr size_t WS_END = 1290 * MiB;
static_assert(WS_WIN + (size_t)D_IN * D * 2 <= WS_WGLU && WS_WGU + (size_t)2 * D_FF * D * 2 <= WS_WDN && WS_WDN + (size_t)D * D_FF * 2 <= WS_HN, "weights map");
static_assert(WS_K + (size_t)BATCH * KVROWS * QKW * 2 <= WS_V && WS_V + (size_t)BATCH * KVROWS * DATT * 2 <= WS_GS && WS_ACT + (size_t)M * D_FF * 2 <= WS_GA, "activation map");
constexpr int CW_TMO = 0, CW_CODE = 1;
constexpr int CW_BAR = 4096;

constexpr int RING_OFF = 0, RING_BYTES = 131072;
constexpr int LDS_BYTES = 147456;
constexpr int BIG_BYTES = LDS_BYTES - 1024;
constexpr int LDSCTL_OFF = BIG_BYTES, MISC_OFF = LDSCTL_OFF + 320;
static_assert(MISC_OFF + 128 <= LDS_BYTES, "LDS map");
#define GAS __attribute__((address_space(1)))
#define LAS __attribute__((address_space(3)))
typedef unsigned short bf16;
typedef unsigned v4u __attribute__((ext_vector_type(4)));
typedef float f32x4 __attribute__((ext_vector_type(4)));
typedef short bf16x8 __attribute__((ext_vector_type(8)));
typedef GAS unsigned gu32;
typedef GAS unsigned long long gu64;
#define RLX_AGENT __ATOMIC_RELAXED, __HIP_MEMORY_SCOPE_AGENT
#define LDS_WAIT() asm volatile("s_waitcnt lgkmcnt(0)" ::: "memory")
#define VM_WAIT() asm volatile("s_waitcnt vmcnt(0)" ::: "memory")
__device__ __forceinline__ unsigned long long rt() { return __builtin_amdgcn_s_memrealtime(); }
__device__ __forceinline__ unsigned f2bf(float f) { unsigned u = __builtin_bit_cast(unsigned, f); return (u + 0x7fffu + ((u >> 16) & 1u)) >> 16; }
__device__ __forceinline__ unsigned pk2(float lo, float hi) { return f2bf(lo) | (f2bf(hi) << 16); }

#define XB_TMO      128
#define XB_XCNT(j)  (256  + 64 * (j))
#define XB_XSUB(j)  (1280 + 64 * (j))
#define XB_XGEN(j)  (2304 + 64 * (j))
#define XB_TOP      3328
#define XB_TOPGEN   3392
#define XCD_BAR_WORDS 3456
#define XB_SPIN_CAP (1u << 18)

__device__ __forceinline__ unsigned xb_ld(unsigned* p)              { return __hip_atomic_load(p, __ATOMIC_RELAXED, __HIP_MEMORY_SCOPE_AGENT); }
__device__ __forceinline__ unsigned xb_add(unsigned* p, unsigned v) { return __hip_atomic_fetch_add(p, v, __ATOMIC_RELAXED, __HIP_MEMORY_SCOPE_AGENT); }
__device__ __forceinline__ unsigned xb_xcc_id() { return (unsigned)__builtin_amdgcn_s_getreg((3 << 11) | 20) & 0xFu; }
#define XB_SPIN(cond, bar) do { unsigned _sp = 0; while (cond) { __builtin_amdgcn_s_sleep(1); \
    if ((++_sp & 255u) == 0u) { if (xb_ld(&(bar)[XB_TMO])) break; if (_sp > XB_SPIN_CAP) { atomicAdd(&(bar)[XB_TMO], 1u); break; } } } } while (0)

struct XcdBarrier {
    unsigned* bar; unsigned x;
    volatile LAS unsigned* st;
};

__device__ __forceinline__ XcdBarrier xcd_barrier_post(unsigned* bar, volatile LAS unsigned* st) {
    XcdBarrier b; b.bar = bar; b.x = xb_xcc_id(); b.st = st;
    if (threadIdx.x == 0) (void)xb_add(&bar[XB_XCNT(b.x)], 1u);
    return b;
}
__device__ __forceinline__ void xcd_barrier_complete(unsigned* bar, unsigned x, unsigned& nloc, unsigned& nx) {
    const unsigned G = gridDim.x * gridDim.y * gridDim.z;
    unsigned sum, cnt, mine, sp = 0u;
    for (;;) {
        sum = 0u; cnt = 0u; mine = 0u;
#pragma unroll
        for (unsigned j = 0; j < 16; ++j) { const unsigned c = xb_ld(&bar[XB_XCNT(j)]); sum += c; cnt += (c > 0u) ? 1u : 0u; mine = (j == x) ? c : mine; }
        if (sum == G) break;
        __builtin_amdgcn_s_sleep(1);
        if ((++sp & 255u) == 0u) { if (xb_ld(&bar[XB_TMO])) break; if (sp > XB_SPIN_CAP) { atomicAdd(&bar[XB_TMO], 1u); break; } }
    }
    nloc = mine > 0u ? mine : 1u; nx = cnt > 0u ? cnt : 1u;
}

__device__ __forceinline__ void xcd_barrier(const XcdBarrier& b) {
    asm volatile("s_waitcnt vmcnt(0)" ::: "memory");
    __syncthreads();
    if (threadIdx.x == 0) {
        unsigned* bar = b.bar;
        __builtin_amdgcn_s_waitcnt(0);
        unsigned nloc = b.st[0], nx = b.st[1];
        if (nloc == 0u) { xcd_barrier_complete(bar, b.x, nloc, nx); b.st[0] = nloc; b.st[1] = nx; }
        const unsigned old = xb_add(&bar[XB_XSUB(b.x)], 1u);
        const unsigned gen = old / nloc;
        if (old + 1u == (gen + 1u) * nloc) {
            __builtin_amdgcn_fence(__ATOMIC_RELEASE, "agent");
            asm volatile("s_waitcnt vmcnt(0)" ::: "memory");
            const unsigned og = xb_add(&bar[XB_TOP], 1u);
            const unsigned tg = og / nx;
            if (og + 1u == (tg + 1u) * nx) xb_add(&bar[XB_TOPGEN], 1u);
            else XB_SPIN(xb_ld(&bar[XB_TOPGEN]) == tg, bar);
            __builtin_amdgcn_fence(__ATOMIC_ACQUIRE, "agent");
            xb_add(&bar[XB_XGEN(b.x)], 1u);
            asm volatile("s_waitcnt vmcnt(0)" ::: "memory");
        } else {
            XB_SPIN(xb_ld(&bar[XB_XGEN(b.x)]) == gen, bar);
            __builtin_amdgcn_fence(__ATOMIC_ACQUIRE, "agent");
            asm volatile("s_waitcnt vmcnt(0)" ::: "memory");
        }
    }
    __syncthreads();
}
struct Frame {
    LAS unsigned char* lds;
    volatile LAS unsigned* MISC;
    gu32* ctl;
    int tid, lane, wave;
    int vcu, G;
    const float* in[27]; float* out; unsigned char* ws;
    bf16 *WinT, *WgluT, *WbraT, *WbrbT, *WoT, *WguT, *WdnT;
    bf16 *HN, *TM, *U, *Q, *K, *V, *GS, *GA, *ACT, *Gb, *YSSM, *HNM, *UM, *KM, *W8, *G8; float *PS, *SSMF;
};
enum { I_X = 0, I_META, I_RELB, I_LN1G, I_WIN, I_QG, I_KG, I_LQ1, I_LK1, I_LQ2, I_LK2, I_SUBG, I_LRE, I_LIM, I_LOGDT, I_BRE, I_BIM, I_CRE, I_CIM, I_DSKIP, I_WGLU, I_BGLU, I_WBR, I_WO, I_LN2G, I_WGU, I_WDN };

__device__ __forceinline__ float wave_sum(float v) {
#pragma unroll
    for (int o = 1; o < 64; o <<= 1) v += __shfl_xor(v, o);
    return v;
}
__device__ __forceinline__ float wave_max(float v) {
#pragma unroll
    for (int o = 1; o < 64; o <<= 1) v = fmaxf(v, __shfl_xor(v, o));
    return v;
}
__device__ __forceinline__ float bf_lo(unsigned w) { return __uint_as_float(w << 16); }
__device__ __forceinline__ float bf_hi(unsigned w) { return __uint_as_float(w & 0xffff0000u); }

enum { RM_ID = 0, RM_IN = 1, RM_GU = 2 };
__device__ __forceinline__ int rowmap(int mode, int n) {
    if (mode == RM_IN) { if (n >= 1024 && n < 5120) { const int base = n - 1024, tile = base >> 8, c = base & 255, w = c >> 6, i = c & 63; return 1024 + tile * 256 + (i >> 5) * 128 + w * 32 + (i & 31); } return n; }
    if (mode == RM_GU) { const int up = n >= D_FF ? 1 : 0; const int j = up ? n - D_FF : n; return (j >> 7) * 256 + up * 128 + (j & 127); }
    return n;
}
__device__ __forceinline__ void p0_transpose_item(const float* W, int K, int N, bf16* WT, int mode, const float* ksc, LAS float* scr, int item, int lane) {
    const int nblk = N / 64, kb = item / nblk, nb = item % nblk, k0 = 64 * kb, n0 = 64 * nb;
    const int kk = lane >> 4, nq = lane & 15;
    f32x4 v[16];
#pragma unroll
    for (int i = 0; i < 16; ++i) v[i] = *(const GAS f32x4*)(W + (size_t)(k0 + 4 * i + kk) * N + n0 + 4 * nq);
    if (ksc) {
#pragma unroll
        for (int i = 0; i < 16; ++i) v[i] = v[i] * ksc[k0 + 4 * i + kk]; }
#pragma unroll
    for (int i = 0; i < 16; ++i) { const int k = 4 * i + kk; *(LAS f32x4*)(scr + k * 64 + 4 * (nq ^ ((k >> 3) & 7))) = v[i]; }
    LDS_WAIT(); asm volatile("" ::: "memory");
    const int c = lane & 7;
#pragma unroll
    for (int j = 0; j < 8; ++j) { const int n = (lane >> 3) + 8 * j; const LAS float* s = scr + (8 * c) * 64 + 4 * ((n >> 2) ^ c) + (n & 3);
        v4u o; o.x = pk2(s[0 * 64], s[1 * 64]); o.y = pk2(s[2 * 64], s[3 * 64]); o.z = pk2(s[4 * 64], s[5 * 64]); o.w = pk2(s[6 * 64], s[7 * 64]);
        *(GAS v4u*)(WT + (size_t)rowmap(mode, n0 + n) * K + k0 + 8 * c) = o; }
    LDS_WAIT(); asm volatile("" ::: "memory");
}
__device__ __forceinline__ void rms_row_to_bf16(const float* xrow, const float* g, bf16* orow, int lane) {
    f32x4 v[8][2]; float s = 0.f;
#pragma unroll
    for (int j = 0; j < 8; ++j) { const GAS f32x4* p = (const GAS f32x4*)(xrow + 512 * j + 8 * lane); v[j][0] = p[0]; v[j][1] = p[1];
        s += ((v[j][0].x * v[j][0].x + v[j][0].y * v[j][0].y) + (v[j][0].z * v[j][0].z + v[j][0].w * v[j][0].w)) + ((v[j][1].x * v[j][1].x + v[j][1].y * v[j][1].y) + (v[j][1].z * v[j][1].z + v[j][1].w * v[j][1].w)); }
    const float r = 1.0f / sqrtf(wave_sum(s) * (1.0f / D) + EPS);
#pragma unroll
    for (int j = 0; j < 8; ++j) { const GAS f32x4* gp = (const GAS f32x4*)(g + 512 * j + 8 * lane); const f32x4 a = v[j][0] * r * gp[0], b = v[j][1] * r * gp[1];
        v4u o; o.x = pk2(a.x, a.y); o.y = pk2(a.z, a.w); o.z = pk2(b.x, b.y); o.w = pk2(b.z, b.w);
        *(GAS v4u*)(orow + 512 * j + 8 * lane) = o; }
}
constexpr int CW_QDN = 2240, CW_QTAIL = 2304;
__device__ __forceinline__ void pull_wdown_items(Frame& F) {
    constexpr int I_DN = (D_FF / 64) * (D / 64);
    LAS float* scr = (LAS float*)(F.lds + RING_OFF + F.wave * 16384);
    volatile LAS unsigned* slot = F.MISC + 14;
    __syncthreads();
    for (;;) {
        if (F.tid == 0) { unsigned idx = __hip_atomic_fetch_add(F.ctl + CW_QDN, 8u, RLX_AGENT); if (idx >= (unsigned)I_DN) idx = 0xffffffffu; *slot = idx; }
        __syncthreads();
        const unsigned idx = *slot;
        if (idx == 0xffffffffu) break;
        const int it = (int)idx + F.wave;
        if (it < I_DN) p0_transpose_item(F.in[I_WDN], D_FF, D, F.WdnT, RM_ID, nullptr, scr, it, F.lane);
        __syncthreads();
    }
    __syncthreads();
}
__device__ __forceinline__ void p0_prologue(Frame& F, int parts) {
    LAS float* scr = (LAS float*)(F.lds + RING_OFF + F.wave * 16384);
    const int gw = F.vcu * NWAVES + F.wave, NGW = F.G * NWAVES;
    constexpr int I_IN = (D / 64) * (D_IN / 64);
    if (parts & 1) for (int it = gw; it < I_IN; it += NGW) p0_transpose_item(F.in[I_WIN], D, D_IN, F.WinT, RM_IN, nullptr, scr, it, F.lane);
    if (parts & 2) for (int m = gw; m < M + NMETA; m += NGW) {
        if (m < M) rms_row_to_bf16(F.in[I_X] + (size_t)m * D, F.in[I_LN1G], F.HN + (size_t)m * D, F.lane);
        else rms_row_to_bf16(F.in[I_META] + (size_t)(m - M) * D, F.in[I_LN1G], F.HNM + (size_t)(m - M) * D, F.lane);
    }
}
constexpr int CW_QITEM = 2048, CW_ARR1 = 2112;
__device__ __forceinline__ void rest_item(Frame& F, LAS float* scr, int r) {
    constexpr int I_GLU = (D_SSM / 64) * (D_SSM / 64), I_BRA = (D_SSM / 64) * (D / 64), I_BRB = (DATT / 64) * (D / 64), I_O = (D / 64) * (D / 64);
    if (r < I_GLU) { p0_transpose_item(F.in[I_WGLU], D_SSM, D_SSM, F.WgluT, RM_ID, nullptr, scr, r, F.lane); return; } r -= I_GLU;
    if (r < I_BRA) { p0_transpose_item(F.in[I_WBR], D_SSM, D, F.WbraT, RM_ID, nullptr, scr, r, F.lane); return; } r -= I_BRA;
    if (r < I_BRB) { p0_transpose_item(F.in[I_WBR] + (size_t)D_SSM * D, DATT, D, F.WbrbT, RM_ID, nullptr, scr, r, F.lane); return; } r -= I_BRB;
    if (r < I_O) { p0_transpose_item(F.in[I_WO], D, D, F.WoT, RM_ID, nullptr, scr, r, F.lane); return; } r -= I_O;
    p0_transpose_item(F.in[I_WGU], D, 2 * D_FF, F.WguT, RM_GU, F.in[I_LN2G], scr, r, F.lane);
}
__device__ __forceinline__ void pull_rest_items(Frame& F, int opportunistic) {
    constexpr int NITEMS = (D_SSM / 64) * (D_SSM / 64) + (D_SSM / 64) * (D / 64) + (DATT / 64) * (D / 64) + (D / 64) * (D / 64) + (D / 64) * (2 * D_FF / 64);
    LAS float* scr = (LAS float*)(F.lds + RING_OFF + F.wave * 16384);
    volatile LAS unsigned* slot = F.MISC + 12;
    __syncthreads();
    for (;;) {
        if (F.tid == 0) { unsigned idx = 0xffffffffu;
            const bool stop = opportunistic && __hip_atomic_load(F.ctl + CW_ARR1, RLX_AGENT) >= (unsigned)F.G;
            if (!stop) { idx = __hip_atomic_fetch_add(F.ctl + CW_QITEM, 8u, RLX_AGENT); if (idx >= (unsigned)NITEMS) idx = 0xffffffffu; }
            *slot = idx; }
        __syncthreads();
        const unsigned idx = *slot;
        if (idx == 0xffffffffu) break;
        const int it = (int)idx + F.wave;
        if (it < NITEMS) rest_item(F, scr, it);
        __syncthreads();
    }
    __syncthreads();
}

__device__ __forceinline__ void pull_rest_half(Frame& F, unsigned num = 1u, unsigned den = 2u) {
    constexpr int NITEMS = (D_SSM / 64) * (D_SSM / 64) + (D_SSM / 64) * (D / 64) + (DATT / 64) * (D / 64) + (D / 64) * (D / 64) + (D / 64) * (2 * D_FF / 64);
    LAS float* scr = (LAS float*)(F.lds + RING_OFF + F.wave * 16384);
    volatile LAS unsigned* slot = F.MISC + 12;
    unsigned target = 0;
    if (F.tid == 0) { const unsigned h0 = __hip_atomic_load(F.ctl + CW_QITEM, RLX_AGENT); target = h0 >= (unsigned)NITEMS ? 0u : h0 + ((unsigned)NITEMS - h0) * num / den; }
    __syncthreads();
    for (;;) {
        if (F.tid == 0) { unsigned idx = 0xffffffffu;
            if (__hip_atomic_load(F.ctl + CW_QITEM, RLX_AGENT) < target) { idx = __hip_atomic_fetch_add(F.ctl + CW_QITEM, 8u, RLX_AGENT); if (idx >= (unsigned)NITEMS) idx = 0xffffffffu; }
            *slot = idx; }
        __syncthreads();
        const unsigned idx = *slot;
        if (idx == 0xffffffffu) break;
        const int it = (int)idx + F.wave;
        if (it < NITEMS) rest_item(F, scr, it);
        __syncthreads();
    }
    __syncthreads();
}

__device__ __forceinline__ void meta_tile(Frame& F, int t) {
        const int lane = F.lane, w = F.wave, l15 = lane & 15, kq = lane >> 4;
        const int type = t < 16 ? 0 : (t < 48 ? 1 : 2), Gi = t - (type == 0 ? 0 : (type == 1 ? 16 : 48));
        const bf16* arow[4];
#pragma unroll
        for (int sb = 0; sb < 4; ++sb) { const int c = 16 * sb + l15;
            const int row = type == 0 ? 64 * Gi + c : (type == 1 ? 3072 + (Gi >> 2) * 256 + (c >> 5) * 128 + (Gi & 3) * 32 + (c & 31) : 5120 + 64 * Gi + c);
            arow[sb] = F.WinT + (size_t)row * D + w * 512 + 8 * kq; }
        const bf16* brow = F.HNM + (size_t)l15 * D + w * 512 + 8 * kq;
        f32x4 acc[4];
#pragma unroll
        for (int sb = 0; sb < 4; ++sb) acc[sb] = (f32x4){0.f, 0.f, 0.f, 0.f};
#pragma unroll 4
        for (int ks = 0; ks < 16; ++ks) { const bf16x8 b = *(const bf16x8*)(brow + 32 * ks);
#pragma unroll
            for (int sb = 0; sb < 4; ++sb) { const bf16x8 a = *(const bf16x8*)(arow[sb] + 32 * ks); acc[sb] = __builtin_amdgcn_mfma_f32_16x16x32_bf16(a, b, acc[sb], 0, 0, 0); } }
        LAS f32x4* part = (LAS f32x4*)(F.lds + RING_OFF);
#pragma unroll
        for (int sb = 0; sb < 4; ++sb) part[(w * 4 + sb) * 64 + lane] = acc[sb];
        __syncthreads();
        if (F.tid < 256) {
            const int j = F.tid >> 4, cq = F.tid & 15, l = j + 16 * (cq & 3), sb = cq >> 2;
            f32x4 v = (f32x4){0.f, 0.f, 0.f, 0.f};
#pragma unroll
            for (int w2 = 0; w2 < 8; ++w2) v += part[(w2 * 4 + sb) * 64 + l];
            if (type == 1) { float ss = (v.x * v.x + v.y * v.y) + (v.z * v.z + v.w * v.w);
                ss += __shfl_xor(ss, 1); ss += __shfl_xor(ss, 2); ss += __shfl_xor(ss, 4); ss += __shfl_xor(ss, 8);
                const float r = 1.0f / sqrtf(ss * (1.0f / 64.0f) + EPS); const f32x4 gn = *(const f32x4*)(F.in[I_KG] + 4 * cq); v = v * r * gn; }
            uint2 o; o.x = pk2(v.x, v.y); o.y = pk2(v.z, v.w);
            if (type == 0) *(uint2*)(F.UM + j * D_SSM + 64 * Gi + 4 * cq) = o;
            else { bf16* base = type == 1 ? F.K : F.V;
#pragma unroll
                for (int b = 0; b < BATCH; ++b) *(uint2*)(base + (size_t)(b * KVROWS + 48 + j) * 2048 + 64 * Gi + 4 * cq) = o; }
        }
    __syncthreads();
}
constexpr int CW_QMETA = 2176;
__device__ __forceinline__ void meta_proj(Frame& F) {
    { const int nth = (int)gridDim.x * NWAVES * 64;
      for (int i = (int)blockIdx.x * NWAVES * 64 + F.tid; i < 2 * BATCH * 48 * 256; i += nth) {
          const int tensor = i / (BATCH * 48 * 256), r = i % (BATCH * 48 * 256), b = r / (48 * 256), rr = (r % (48 * 256)) / 256, ch = r % 256;
          bf16* p = (tensor ? F.V : F.K) + (size_t)(b * KVROWS + rr) * 2048 + ch * 8;
          *(v4u*)p = (v4u){0u, 0u, 0u, 0u}; } }
    volatile LAS unsigned* slot = F.MISC + 13;
    __syncthreads();
    for (;;) {
        if (F.tid == 0) *slot = __hip_atomic_fetch_add(F.ctl + CW_QMETA, 1u, RLX_AGENT);
        __syncthreads();
        const unsigned t = *slot;
        if (t >= 80u) break;
        meta_tile(F, (int)t);
    }
    __syncthreads();
}

__device__ __forceinline__ float gelu_tanh(float x) { const float z = 0.7978845608028654f * (x + 0.044715f * x * x * x); const float e = __expf(2.0f * z); return 0.5f * x * (2.0f - 2.0f / (e + 1.0f)); }
constexpr int BB_LD = 132;
__device__ __forceinline__ float diff_lambda(Frame& F) {
    const float s1 = wave_sum(F.in[I_LQ1][F.lane] * F.in[I_LK1][F.lane]), s2 = wave_sum(F.in[I_LQ2][F.lane] * F.in[I_LK2][F.lane]);
    return expf(s1) - expf(s2) + LAMBDA_INIT;
}
namespace att {
typedef float f32x16 __attribute__((ext_vector_type(16)));
typedef short s16x4 __attribute__((ext_vector_type(4)));
typedef short v4i16_t __attribute__((ext_vector_type(4)));
typedef LAS const char* lds_cptr;
typedef unsigned u32x4 __attribute__((ext_vector_type(4)));
constexpr int SLOT = 16384, NSLOT = 4, L_K = 0, L_V = NSLOT * SLOT, L_BB = 2 * NSLOT * SLOT, L_WS = L_BB + 8704, L_END = L_WS + NWAVES * 256;
constexpr int L_X = 0, L_STG = L_V;
static_assert(NH * BB_LD * 4 <= 8704 && L_END <= BIG_BYTES && 4 * 16384 <= NSLOT * SLOT, "attention LDS map");
__device__ __forceinline__ int crow(int r, int hi) { return (r & 3) + 8 * (r >> 2) + 4 * hi; }
__device__ __forceinline__ void glds16(const void* gsrc, unsigned lds_dst) { unsigned keep;
    asm volatile("s_mov_b32 %0, m0\n\ts_mov_b32 m0, %2\n\ts_nop 0\n\tglobal_load_lds_dwordx4 %1, off\n\ts_mov_b32 m0, %0" : "=&s"(keep) : "v"(gsrc), "s"(lds_dst) : "memory"); }
__device__ __forceinline__ s16x4 vtr(lds_cptr p) { return __builtin_bit_cast(s16x4, __builtin_amdgcn_ds_read_tr16_b64_v4i16((LAS v4i16_t*)p)); }
__device__ __forceinline__ unsigned cvtpk(float lo, float hi) { typedef float f2 __attribute__((ext_vector_type(2))); typedef __bf16 b2 __attribute__((ext_vector_type(2))); f2 v = {lo, hi}; b2 b = __builtin_convertvector(v, b2); return __builtin_bit_cast(unsigned, b); }
#define ATT_WAIT_BAR() asm volatile("s_waitcnt vmcnt(0) lgkmcnt(0)\n\ts_barrier" ::: "memory")

__device__ __forceinline__ void build_rel_bias_table(Frame& F, LAS float* bbt) {
    const float* rb = F.in[I_RELB];
    for (int idx = F.tid; idx < NH * 129; idx += NWAVES * 64) { const int h = idx / 129, d = idx % 129;
        int bucket = d; if (d >= 16) { bucket = 16 + (int)(logf((float)d * (1.0f / 16.0f)) / 2.0794415416798357f * 16.0f); bucket = bucket > 31 ? 31 : bucket; }
        bbt[h * BB_LD + d] = (rb[bucket * NH + h] - rb[31 * NH + h]) * LOG2E; }
    for (int h = F.tid; h < NH; h += NWAVES * 64) bbt[h * BB_LD + 129] = -1e30f;
}
__device__ __forceinline__ void qk_half(f32x16& s, lds_cptr kp, const int (&ko)[4], const bf16x8 (&qr)[4]) {
    const f32x16 z = {0.f, 0.f, 0.f, 0.f, 0.f, 0.f, 0.f, 0.f, 0.f, 0.f, 0.f, 0.f, 0.f, 0.f, 0.f, 0.f};
#pragma unroll
    for (int d0 = 0; d0 < 4; ++d0) { const bf16x8 a = *(const LAS bf16x8*)(kp + ko[d0]); s = __builtin_amdgcn_mfma_f32_32x32x16_bf16(a, qr[d0], d0 == 0 ? z : s, 0, 0, 0); }
}
__device__ __forceinline__ void band_fix(f32x16& s, const LAS float* bb, int dbase, int pos4) {
#pragma unroll
    for (int r = 0; r < 16; ++r) { const int ko = (r & 3) + 8 * (r >> 2);
        const int dist = dbase - ko, pos = pos4 + ko; const bool valid = dist >= 0 && pos >= -NMETA; const int idx = valid ? (dist > 128 ? 128 : dist) : 129;
        s[r] += bb[idx]; }
}
__device__ __forceinline__ void exp_pack(f32x16& s, float& l, u32x4& pa, u32x4& pb) {
    float acc = 0.f;
#pragma unroll
    for (int r = 0; r < 16; ++r) { s[r] = __builtin_amdgcn_exp2f(s[r]); acc += s[r]; }
    l += acc;
    pa = (u32x4){cvtpk(s[0], s[1]), cvtpk(s[2], s[3]), cvtpk(s[4], s[5]), cvtpk(s[6], s[7])};
    pb = (u32x4){cvtpk(s[8], s[9]), cvtpk(s[10], s[11]), cvtpk(s[12], s[13]), cvtpk(s[14], s[15])};
}
#define ATT_SB() do {} while (0)
__device__ __forceinline__ void v_frags(bf16x8 (&vf)[4], lds_cptr vp, int eb) {
#pragma unroll
    for (int ks = 0; ks < 4; ++ks) { const s16x4 lo = vtr(vp + (eb >> 1) * 8192 + (eb & 1) * 512 + ks * 2048), hh = vtr(vp + (eb >> 1) * 8192 + (eb & 1) * 512 + ks * 2048 + 1024);
        vf[ks] = (bf16x8){lo[0], lo[1], lo[2], lo[3], hh[0], hh[1], hh[2], hh[3]}; }
}
__device__ __forceinline__ void tile_compute(bool BAND, f32x16 (&O)[4], float& l, const bf16x8 (&q)[4], lds_cptr kp, const int (&ko)[4], lds_cptr vp, const LAS float* bb, int dbase, int pos4) {
    const f32x16 z = {0.f, 0.f, 0.f, 0.f, 0.f, 0.f, 0.f, 0.f, 0.f, 0.f, 0.f, 0.f, 0.f, 0.f, 0.f, 0.f};
    bf16x8 kf[8];
#pragma unroll
    for (int d0 = 0; d0 < 4; ++d0) { kf[d0] = *(const LAS bf16x8*)(kp + ko[d0]); kf[4 + d0] = *(const LAS bf16x8*)(kp + 8192 + ko[d0]); }
    bf16x8 va[4], vb[4];
    v_frags(va, vp, 0);
    __builtin_amdgcn_sched_barrier(0);
    f32x16 s0, s1;
#pragma unroll
    for (int d0 = 0; d0 < 4; ++d0) { s0 = __builtin_amdgcn_mfma_f32_32x32x16_bf16(kf[d0], q[d0], d0 == 0 ? z : s0, 0, 0, 0); s1 = __builtin_amdgcn_mfma_f32_32x32x16_bf16(kf[4 + d0], q[d0], d0 == 0 ? z : s1, 0, 0, 0); }
    u32x4 pa[4];
    if (BAND) { band_fix(s0, bb, dbase, pos4); band_fix(s1, bb, dbase - 32, pos4 + 32); }
    exp_pack(s0, l, pa[0], pa[1]); exp_pack(s1, l, pa[2], pa[3]);
    __builtin_amdgcn_sched_barrier(0);
    v_frags(vb, vp, 1);
#pragma unroll
    for (int ks = 0; ks < 4; ++ks) O[0] = __builtin_amdgcn_mfma_f32_32x32x16_bf16(__builtin_bit_cast(bf16x8, pa[ks]), va[ks], O[0], 0, 0, 0);
    __builtin_amdgcn_sched_barrier(0);
    v_frags(va, vp, 2);
#pragma unroll
    for (int ks = 0; ks < 4; ++ks) O[1] = __builtin_amdgcn_mfma_f32_32x32x16_bf16(__builtin_bit_cast(bf16x8, pa[ks]), vb[ks], O[1], 0, 0, 0);
    __builtin_amdgcn_sched_barrier(0);
    v_frags(vb, vp, 3);
#pragma unroll
    for (int ks = 0; ks < 4; ++ks) O[2] = __builtin_amdgcn_mfma_f32_32x32x16_bf16(__builtin_bit_cast(bf16x8, pa[ks]), va[ks], O[2], 0, 0, 0);
    __builtin_amdgcn_sched_barrier(0);
#pragma unroll
    for (int ks = 0; ks < 4; ++ks) O[3] = __builtin_amdgcn_mfma_f32_32x32x16_bf16(__builtin_bit_cast(bf16x8, pa[ks]), vb[ks], O[3], 0, 0, 0);
}
__device__ __forceinline__ void attn_unit(Frame& F, int b, int h, int qb, float lam, bf16* dst) {
    const int lane = F.lane, r32 = lane & 31, hi = lane >> 5, wid = F.wave, qblk = wid & 3, map = wid >> 2;
    const unsigned lds0 = (unsigned)(uintptr_t)(F.lds + RING_OFF);
    const lds_cptr L = (lds_cptr)(F.lds + RING_OFF);
    const int q0 = qb * 128, qmin = q0 + 32 * qblk, NT = 2 * qb + 3;
    const bf16* Kb = F.K + (size_t)(b * KVROWS) * QKW + h * 128; const bf16* Vb = F.V + (size_t)(b * KVROWS) * DATT + h * 128;
    const bf16* ksrc = Kb + (size_t)(4 * wid + (lane >> 4)) * QKW + (((lane & 15) ^ ((4 * wid + (lane >> 4)) & 15)) * 8);
    const bf16* vsrc = Vb + (size_t)(8 * wid + ((lane >> 2) & 7)) * DATT + (lane >> 5) * 32 + (lane & 3) * 8;
    const unsigned kdst = lds0 + L_K + wid * 1024, vdst = lds0 + L_V + wid * 1024;
#define ATT_DMA(T, slot) do { const size_t go_ = (size_t)(T) * 64 * QKW; const unsigned so_ = (unsigned)(slot) * SLOT; \
        glds16(ksrc + go_, (unsigned)__builtin_amdgcn_readfirstlane(kdst + so_)); glds16(ksrc + go_ + (size_t)32 * QKW, (unsigned)__builtin_amdgcn_readfirstlane(kdst + so_ + 8192)); \
        glds16(vsrc + go_, (unsigned)__builtin_amdgcn_readfirstlane(vdst + so_)); glds16(vsrc + go_ + 64, (unsigned)__builtin_amdgcn_readfirstlane(vdst + so_ + 8192)); } while (0)
    bf16* Qw = F.Q + (size_t)(b * SEQ + qmin + r32) * QKW + h * 128 + map * 64 + hi * 8;
    bf16x8 q[4];
#pragma unroll
    for (int d0 = 0; d0 < 4; ++d0) q[d0] = *(const bf16x8*)(Qw + d0 * 16);
#pragma unroll
    for (int d0 = 0; d0 < 4; ++d0) asm volatile("" : "+v"(q[d0]));
    asm volatile("s_waitcnt lgkmcnt(0)\n\ts_barrier" ::: "memory");
    ATT_DMA(0, 0); ATT_DMA(1, 1); ATT_DMA(2, 2);
    f32x16 O[4];
#pragma unroll
    for (int eb = 0; eb < 4; ++eb)
#pragma unroll
        for (int r = 0; r < 16; ++r) O[eb][r] = 0.f;
    float l = 0.f;
    const LAS float* bb = (const LAS float*)(F.lds + RING_OFF + L_BB) + h * BB_LD;
    const int vlane = ((lane >> 4) & 1) * 32 + (lane & 3) * 8 + (4 * hi + ((lane & 15) >> 2)) * 64;
    int ko[4];
#pragma unroll
    for (int d0 = 0; d0 < 4; ++d0) ko[d0] = r32 * 256 + (((map * 8 + 2 * d0 + hi) ^ (r32 & 15)) * 16);
    const int NTw = (qmin + 95) / 64 + 1 < NT ? (qmin + 95) / 64 + 1 : NT;
#define ATT_STEP_SYNC(T) do { if ((T) + 2 < NT) asm volatile("s_waitcnt vmcnt(8) lgkmcnt(0)\n\ts_barrier" ::: "memory"); \
        else if ((T) + 1 < NT) asm volatile("s_waitcnt vmcnt(4) lgkmcnt(0)\n\ts_barrier" ::: "memory"); \
        else asm volatile("s_waitcnt vmcnt(0) lgkmcnt(0)\n\ts_barrier" ::: "memory"); \
        if ((T) + 3 < NT) ATT_DMA((T) + 3, ((T) + 3) & 3); } while (0)
#pragma clang loop unroll(disable)
    for (int T = 0; T < NTw; ++T) {
        ATT_STEP_SYNC(T);
        const int pos0 = 64 * T - 64;
        const lds_cptr kp = L + L_K + (T & 3) * SLOT, vp = L + L_V + (T & 3) * SLOT + vlane;
        const bool band = !(T >= 1 && pos0 + 63 + 128 <= qmin);
        tile_compute(band, O, l, q, kp, ko, vp, bb, qmin + r32 - pos0 - 4 * hi, pos0 + 4 * hi);
    }
#pragma clang loop unroll(disable)
    for (int T = NTw; T < NT; ++T) ATT_STEP_SYNC(T);
#undef ATT_STEP_SYNC
#undef ATT_DMA
    l += __shfl_xor(l, 32);
    LAS float* wsf = (LAS float*)(F.lds + RING_OFF + L_WS) + wid * 64;
    if (hi == 0) wsf[r32] = (map ? lam : 1.0f) / l;
    asm volatile("s_waitcnt lgkmcnt(0)\n\ts_barrier" ::: "memory");
    float sc[16];
#pragma unroll
    for (int r = 0; r < 16; ++r) sc[r] = wsf[crow(r, hi)];
    LAS float* X = (LAS float*)(F.lds + RING_OFF + L_X) + qblk * 4096 + lane;
    if (map) {
#pragma unroll
        for (int eb = 0; eb < 4; ++eb)
#pragma unroll
            for (int r = 0; r < 16; ++r) X[(eb * 16 + r) * 64] = O[eb][r] * sc[r];
    }
    asm volatile("s_waitcnt lgkmcnt(0)\n\ts_barrier" ::: "memory");
    if (map == 0) {
        float ss[16];
#pragma unroll
        for (int r = 0; r < 16; ++r) { float s = 0.f;
#pragma unroll
            for (int eb = 0; eb < 4; ++eb) { const float o = O[eb][r] * sc[r] - X[(eb * 16 + r) * 64]; O[eb][r] = o; s += o * o; }
            ss[r] = s; }
#pragma unroll
        for (int r = 0; r < 16; ++r) { float s = ss[r]; s += __shfl_xor(s, 1); s += __shfl_xor(s, 2); s += __shfl_xor(s, 4); s += __shfl_xor(s, 8); s += __shfl_xor(s, 16);
            ss[r] = (1.0f - LAMBDA_INIT) / sqrtf(s * (1.0f / VD) + EPS); }
        float sg[4];
#pragma unroll
        for (int eb = 0; eb < 4; ++eb) sg[eb] = F.in[I_SUBG][32 * eb + r32];
        LAS bf16* stg = (LAS bf16*)(F.lds + RING_OFF + L_STG) + qblk * 2048;
        bf16* Ow = dst + (size_t)(b * SEQ + qmin) * QKW + h * 128;
#pragma unroll
        for (int half = 0; half < 2; ++half) {
#pragma unroll
            for (int r = 0; r < 16; ++r) { const int orow = crow(r, hi);
#pragma unroll
                for (int e2 = 0; e2 < 2; ++e2) { const int eb = 2 * half + e2; stg[orow * 64 + e2 * 32 + r32] = (bf16)f2bf(O[eb][r] * ss[r] * sg[eb]); } }
            asm volatile("s_waitcnt lgkmcnt(0)" ::: "memory");
#pragma unroll
            for (int i = 0; i < 4; ++i) { const int row = i * 8 + (lane >> 3), ch = lane & 7; const v4u v = *(const LAS v4u*)(stg + row * 64 + ch * 8); *(v4u*)(Ow + (size_t)row * QKW + half * 64 + ch * 8) = v; }
            asm volatile("s_waitcnt lgkmcnt(0)" ::: "memory");
        }
    }
}
__device__ __forceinline__ void attn_phase(Frame& F, bf16* dst) {
    build_rel_bias_table(F, (LAS float*)(F.lds + RING_OFF + L_BB));
    __syncthreads();
    const float lam = diff_lambda(F);
#pragma clang loop unroll(disable)
    for (int k = 0; ; ++k) { const int pr = F.vcu + (k >> 1) * F.G; if (pr >= BATCH * NH * 16) break;
        const int bh = pr >> 4, j = pr & 15;
        attn_unit(F, bh >> 4, bh & 15, (k & 1) ? j : 31 - j, lam, dst); }
    asm volatile("s_waitcnt vmcnt(0) lgkmcnt(0)" ::: "memory");
    __syncthreads();
}
}
namespace ssm {
constexpr int KM_ELEMS = 66 * 256, T8_ELEMS = 128 * 128, SF_STRIDE = 4608;
constexpr int SF_A = 0, SF_A8 = 128, SF_P64 = 256, SF_BB = 256 + 17 * 128;
static_assert(SF_BB + 64 * 16 * 2 <= SF_STRIDE, "ssm f32 table");
constexpr int L_KM = 0, L_US = 33792, L_SIN = L_US + 2 * 32768, L_END = L_SIN + 32768;
static_assert(KM_ELEMS * 2 <= L_US && L_END <= BIG_BYTES, "ssm LDS map");
typedef float f2 __attribute__((ext_vector_type(2)));
typedef unsigned u2v __attribute__((ext_vector_type(2)));
__device__ __forceinline__ f2 cmul(f2 a, f2 b) { return (f2){a.x * b.x - a.y * b.y, a.x * b.y + a.y * b.x}; }

__device__ __forceinline__ void p0_tables(Frame& F) {
    LAS f2* apw = (LAS f2*)(F.lds + RING_OFF);
    LAS f2* bbl = apw + 65 * 64;
    LAS f2* cl = bbl + 64 * 16;
    for (int gp = F.vcu; gp < NGRP * 4; gp += F.G) {
        const int g = gp >> 2, part = gp & 3;
        const double dt = exp((double)F.in[I_LOGDT][g]);
        __syncthreads();
        if (F.tid < 64) { const int p = F.tid;
            const double lre = F.in[I_LRE][g * 64 + p], lim = F.in[I_LIM][g * 64 + p], er = exp(lre * dt), ar = er * cos(lim * dt), ai = er * sin(lim * dt);
            double pr = 1.0, pi = 0.0, a64r = 1.0, a64i = 0.0;
            for (int n = 0; n <= 64; ++n) { apw[n * 64 + p] = (f2){(float)pr, (float)pi}; a64r = pr; a64i = pi; const double t = pr * ar - pi * ai; pi = pr * ai + pi * ar; pr = t; }
            if (part == 2) { float* sf = F.SSMF + (size_t)g * SF_STRIDE; double qr = 1.0, qi = 0.0;
                for (int n = 0; n <= 16; ++n) { ((f2*)(sf + SF_P64))[n * 64 + p] = (f2){(float)qr, (float)qi}; const double t = qr * a64r - qi * a64i; qi = qr * a64i + qi * a64r; qr = t; } } }
        for (int idx = F.tid; idx < 64 * 16; idx += NWAVES * 64) { const int p = idx >> 4, c = idx & 15;
            const double lre = F.in[I_LRE][g * 64 + p], lim = F.in[I_LIM][g * 64 + p], er = exp(lre * dt), ar = er * cos(lim * dt), ai = er * sin(lim * dt);
            const double nr = ar - 1.0, ni = ai, den = lre * lre + lim * lim, fr = (nr * lre + ni * lim) / den, fi = (ni * lre - nr * lim) / den;
            const double br = F.in[I_BRE][(g * 64 + p) * 16 + c], bi = F.in[I_BIM][(g * 64 + p) * 16 + c];
            bbl[idx] = (f2){(float)(fr * br - fi * bi), (float)(fr * bi + fi * br)}; }
        for (int idx = F.tid; idx < 16 * 64; idx += NWAVES * 64) { const int c = idx >> 6, p = idx & 63; cl[idx] = (f2){F.in[I_CRE][(g * 16 + c) * 64 + p], F.in[I_CIM][(g * 16 + c) * 64 + p]}; }
        __syncthreads();
        bf16* km = F.KM + (size_t)g * KM_ELEMS;
        for (int idx = F.tid; idx < 16 * 256; idx += NWAVES * 64) { const int lag = 16 * part + (idx >> 8), c = (idx >> 4) & 15, c2 = idx & 15; float s = 0.f;
            for (int p = 0; p < 64; ++p) { const f2 z = cmul(cl[c * 64 + p], apw[lag * 64 + p]), b = bbl[p * 16 + c2]; s += z.x * b.x - z.y * b.y; }
            km[(lag + 2) * 256 + c * 16 + c2] = (bf16)f2bf(s); }
        if (part == 0) { for (int idx = F.tid; idx < 512; idx += NWAVES * 64) km[idx] = 0;
            bf16* w8 = F.W8 + (size_t)g * T8_ELEMS;
            for (int idx = F.tid; idx < T8_ELEMS; idx += NWAVES * 64) { const int row = idx >> 7, col = idx & 127, p = row >> 1, ri = row & 1, i2 = col >> 4, c2 = col & 15;
                const f2 z = cmul(apw[(7 - i2) * 64 + p], bbl[p * 16 + c2]); w8[idx] = (bf16)f2bf(ri ? z.y : z.x); } }
        if (part == 1) { bf16* g8 = F.G8 + (size_t)g * T8_ELEMS;
            for (int idx = F.tid; idx < T8_ELEMS; idx += NWAVES * 64) { const int row = idx >> 7, col = idx & 127, j2 = row >> 4, c = row & 15, p = col >> 1, ri = col & 1;
                const f2 z = cmul(cl[c * 64 + p], apw[(j2 + 1) * 64 + p]); g8[idx] = (bf16)f2bf(ri ? -z.y : z.x); } }
        if (part == 2) { float* sf = F.SSMF + (size_t)g * SF_STRIDE;
            for (int p = F.tid; p < 64; p += NWAVES * 64) { ((f2*)(sf + SF_A))[p] = apw[1 * 64 + p]; ((f2*)(sf + SF_A8))[p] = apw[8 * 64 + p]; }
            for (int idx = F.tid; idx < 64 * 16; idx += NWAVES * 64) ((f2*)(sf + SF_BB))[idx] = bbl[idx]; }
    }
    __syncthreads();
}

__device__ __forceinline__ void glds16(const void* gsrc, unsigned lds_dst) { unsigned keep;
    asm volatile("s_mov_b32 %0, m0\n\ts_mov_b32 m0, %2\n\ts_nop 0\n\tglobal_load_lds_dwordx4 %1, off\n\ts_mov_b32 m0, %0" : "=&s"(keep) : "v"(gsrc), "s"(lds_dst) : "memory"); }
__device__ __forceinline__ float shfl_up16(float v, int d, int l15) { const float t = __shfl_up(v, d, 16); return l15 >= d ? t : 0.f; }

__device__ __forceinline__ void ssm_unit(Frame& F, int g, int b) {
    const int lane = F.lane, w = F.wave, l15 = lane & 15, kq = lane >> 4;
    const unsigned lds0 = (unsigned)(uintptr_t)(F.lds + RING_OFF);
    LAS const char* L = (LAS const char*)(F.lds + RING_OFF);
    __syncthreads();
    { const v4u* kmg = (const v4u*)(F.KM + (size_t)g * KM_ELEMS); LAS v4u* kml = (LAS v4u*)(F.lds + RING_OFF + L_KM);
      for (int i = F.tid; i < KM_ELEMS / 8; i += NWAVES * 64) kml[i] = kmg[i]; }
    const bf16* usrc = F.U + ((size_t)(b * SEQ) + ((lane >> 1) & 15) * 64 + (lane >> 5)) * D_SSM + g * 16 + (lane & 1) * 8;
#define SSM_SLAB(nt, buf) do { _Pragma("unroll") for (int r_ = 0; r_ < 4; ++r_) { const int q_ = w * 4 + r_; \
        glds16(usrc + ((size_t)(nt) * 1024 + 2 * q_) * D_SSM, (unsigned)__builtin_amdgcn_readfirstlane(lds0 + L_US + (buf) * 32768 + q_ * 1024)); } } while (0)
    SSM_SLAB(0, 0);
    const float* sf = F.SSMF + (size_t)g * SF_STRIDE;
    const int pa = 8 * w + 2 * kq;
    const f2 a8a = ((const f2*)(sf + SF_A8))[pa], a8b = ((const f2*)(sf + SF_A8))[pa + 1];
    const f2* p64 = (const f2*)(sf + SF_P64);
    const f2 pna = p64[l15 * 64 + pa], pnb = p64[l15 * 64 + pa + 1], p16a = p64[16 * 64 + pa], p16b = p64[16 * 64 + pa + 1];
    bf16x8 w8f[4], g8f[4];
#pragma unroll
    for (int ks = 0; ks < 4; ++ks) { w8f[ks] = *(const bf16x8*)(F.W8 + (size_t)g * T8_ELEMS + (16 * w + l15) * 128 + 32 * ks + 8 * kq);
                                     g8f[ks] = *(const bf16x8*)(F.G8 + (size_t)g * T8_ELEMS + (16 * w + l15) * 128 + 32 * ks + 8 * kq); }
    const f32x4 dsk = *(const f32x4*)(F.in[I_DSKIP] + g * 16 + 4 * kq);
    f2 s0a = {0.f, 0.f}, s0b = {0.f, 0.f};
    { const f2 aa = ((const f2*)(sf + SF_A))[pa], ab = ((const f2*)(sf + SF_A))[pa + 1]; const f2* bba = (const f2*)(sf + SF_BB) + pa * 16; const f2* bbb = bba + 16;
      const v4u mu0 = *(const v4u*)(F.UM + l15 * D_SSM + g * 16), mu1 = *(const v4u*)(F.UM + l15 * D_SSM + g * 16 + 8);
      f2 bva[16], bvb[16];
#pragma unroll
      for (int c = 0; c < 16; ++c) { bva[c] = bba[c]; bvb[c] = bbb[c]; }
#pragma unroll
      for (int j = 0; j < NMETA; ++j) {
          const unsigned x0 = __builtin_amdgcn_readlane(mu0.x, j), x1 = __builtin_amdgcn_readlane(mu0.y, j), x2 = __builtin_amdgcn_readlane(mu0.z, j), x3 = __builtin_amdgcn_readlane(mu0.w, j);
          const unsigned x4 = __builtin_amdgcn_readlane(mu1.x, j), x5 = __builtin_amdgcn_readlane(mu1.y, j), x6 = __builtin_amdgcn_readlane(mu1.z, j), x7 = __builtin_amdgcn_readlane(mu1.w, j);
          float u[16];
          u[0] = bf_lo(x0); u[1] = bf_hi(x0); u[2] = bf_lo(x1); u[3] = bf_hi(x1); u[4] = bf_lo(x2); u[5] = bf_hi(x2); u[6] = bf_lo(x3); u[7] = bf_hi(x3);
          u[8] = bf_lo(x4); u[9] = bf_hi(x4); u[10] = bf_lo(x5); u[11] = bf_hi(x5); u[12] = bf_lo(x6); u[13] = bf_hi(x6); u[14] = bf_lo(x7); u[15] = bf_hi(x7);
          f2 ba = {0.f, 0.f}, bb_ = {0.f, 0.f};
#pragma unroll
          for (int c = 0; c < 16; ++c) { ba += bva[c] * u[c]; bb_ += bvb[c] * u[c]; }
          s0a = cmul(aa, s0a) + ba; s0b = cmul(ab, s0b) + bb_; } }
    const int boff = (kq >> 1) * 512 + l15 * 32 + (kq & 1) * 16;
    const int aoff = L_KM + (32 - (kq >> 1) * 16 + l15) * 32 + (kq & 1) * 16;
    const int soff = L_SIN + ((2 * w + (kq >> 1)) * 16 + l15) * 16 + (kq & 1) * 8;
    const int sfrag = L_SIN + (kq * 16 + l15) * 16;
    for (int nt = 0; nt < 4; ++nt) {
        asm volatile("s_waitcnt vmcnt(0) lgkmcnt(0)\n\ts_barrier" ::: "memory");
        if (nt + 1 < 4) SSM_SLAB(nt + 1, (nt + 1) & 1);
        const LAS char* slab = L + L_US + (nt & 1) * 32768;
        f2 ea, eb;
#pragma unroll
        for (int s = 0; s < 8; ++s) { f32x4 acc = {0.f, 0.f, 0.f, 0.f};
            bf16x8 bfs[4];
#pragma unroll
            for (int ks = 0; ks < 4; ++ks) bfs[ks] = *(const LAS bf16x8*)(slab + (8 * s + 2 * ks) * 512 + boff);
#pragma unroll
            for (int ks = 0; ks < 4; ++ks) acc = __builtin_amdgcn_mfma_f32_16x16x32_bf16(w8f[ks], bfs[ks], acc, 0, 0, 0);
            if (s == 0) { ea = (f2){acc[0], acc[1]}; eb = (f2){acc[2], acc[3]}; }
            else { ea = cmul(ea, a8a) + (f2){acc[0], acc[1]}; eb = cmul(eb, a8b) + (f2){acc[2], acc[3]}; } }
#pragma unroll
        for (int d = 1; d < 16; d <<= 1) { const f2 wa = p64[d * 64 + pa], wb = p64[d * 64 + pa + 1];
            const f2 qa = {shfl_up16(ea.x, d, l15), shfl_up16(ea.y, d, l15)}, qb = {shfl_up16(eb.x, d, l15), shfl_up16(eb.y, d, l15)};
            ea += cmul(wa, qa); eb += cmul(wb, qb); }
        f2 sa = cmul(pna, s0a) + (f2){shfl_up16(ea.x, 1, l15), shfl_up16(ea.y, 1, l15)};
        f2 sb = cmul(pnb, s0b) + (f2){shfl_up16(eb.x, 1, l15), shfl_up16(eb.y, 1, l15)};
        { const int src = (lane & 48) | 15;
          const f2 la = {__shfl(ea.x, src), __shfl(ea.y, src)}, lb = {__shfl(eb.x, src), __shfl(eb.y, src)};
          s0a = cmul(p16a, s0a) + la; s0b = cmul(p16b, s0b) + lb; }
#pragma unroll
        for (int s = 0; s < 8; ++s) {
            u2v o; o.x = pk2(sa.x, sa.y); o.y = pk2(sb.x, sb.y);
            *(LAS u2v*)(F.lds + RING_OFF + soff + s * 4096) = o;
            sa = cmul(sa, a8a); sb = cmul(sb, a8b); }
        asm volatile("s_waitcnt lgkmcnt(0)\n\ts_barrier" ::: "memory");
        f32x4 acc[8];
#pragma unroll
        for (int jj = 0; jj < 8; ++jj) acc[jj] = (f32x4){0.f, 0.f, 0.f, 0.f};
#pragma unroll 2
        for (int ks = 0; ks < 32; ++ks) { const int i0 = 2 * ks;
            const bf16x8 bf = *(const LAS bf16x8*)(slab + i0 * 512 + boff);
            bf16x8 af[8];
#pragma unroll
            for (int jj = 0; jj < 8; ++jj) { int d = w + 8 * jj - i0; d = d < -1 ? -1 : d; af[jj] = *(const LAS bf16x8*)(L + aoff + d * 512); }
#pragma unroll
            for (int jj = 0; jj < 8; ++jj) acc[jj] = __builtin_amdgcn_mfma_f32_16x16x32_bf16(af[jj], bf, acc[jj], 0, 0, 0); }
#pragma unroll
        for (int jj = 0; jj < 8; ++jj)
#pragma unroll
            for (int ks = 0; ks < 4; ++ks) { const bf16x8 bf = *(const LAS bf16x8*)(L + sfrag + jj * 4096 + ks * 1024); acc[jj] = __builtin_amdgcn_mfma_f32_16x16x32_bf16(g8f[ks], bf, acc[jj], 0, 0, 0); }
#pragma unroll
        for (int jj = 0; jj < 8; ++jj) { const int j = w + 8 * jj;
            const u2v uu = *(const LAS u2v*)(slab + j * 512 + l15 * 32 + kq * 8);
            const float y0 = acc[jj][0] + dsk[0] * bf_lo(uu.x), y1 = acc[jj][1] + dsk[1] * bf_hi(uu.x), y2 = acc[jj][2] + dsk[2] * bf_lo(uu.y), y3 = acc[jj][3] + dsk[3] * bf_hi(uu.y);
            u2v o; o.x = pk2(gelu_tanh(y0), gelu_tanh(y1)); o.y = pk2(gelu_tanh(y2), gelu_tanh(y3));
            *(u2v*)(F.Gb + ((size_t)(b * SEQ) + nt * 1024 + l15 * 64 + j) * D_SSM + g * 16 + 4 * kq) = o; }
    }
#undef SSM_SLAB
    asm volatile("s_waitcnt vmcnt(0) lgkmcnt(0)" ::: "memory");
    __syncthreads();
}
__device__ __forceinline__ void ssm_phase(Frame& F) {
    for (int un = F.vcu; un < NGRP * BATCH; un += F.G) ssm_unit(F, un >> 2, un & 3);
}
}
#ifndef PROBE_MASK
#define PROBE_MASK 0xff
#endif
#define PROBE_PH(k) (((PROBE_MASK) >> (k)) & 1)
struct Args { const float* in[27]; float* out; unsigned char* ws; int ph_lo, ph_hi, li, pad; };
__global__ void __launch_bounds__(NWAVES * 64, 2) mk_fwd(Args args) {
    extern __shared__ __attribute__((aligned(16))) unsigned char lds[];
    Frame F;
    F.lds = (LAS unsigned char*)lds;
    F.MISC = (volatile LAS unsigned*)(F.lds + MISC_OFF);
    F.tid = threadIdx.x; F.lane = F.tid & 63; F.wave = __builtin_amdgcn_readfirstlane(F.tid >> 6);
    F.G = gridDim.x; { const int bx = blockIdx.x; F.vcu = (F.G % 8 == 0) ? (bx % 8) * (F.G / 8) + bx / 8 : bx; }
    unsigned char* ws = args.ws; F.ws = ws; F.out = args.out;
#pragma unroll
    for (int i = 0; i < 27; ++i) F.in[i] = args.in[i];
    F.ctl = (gu32*)(ws + WS_CTL);
    F.WinT = (bf16*)(ws + WS_WIN); F.WgluT = (bf16*)(ws + WS_WGLU); F.WbraT = (bf16*)(ws + WS_WBRA); F.WbrbT = (bf16*)(ws + WS_WBRB); F.WoT = (bf16*)(ws + WS_WO); F.WguT = (bf16*)(ws + WS_WGU); F.WdnT = (bf16*)(ws + WS_WDN);
    F.HN = (bf16*)(ws + WS_HN); F.TM = (bf16*)(ws + WS_TM); F.U = (bf16*)(ws + WS_U); F.Q = (bf16*)(ws + WS_Q); F.K = (bf16*)(ws + WS_K); F.V = (bf16*)(ws + WS_V); F.GS = (bf16*)(ws + WS_GS); F.GA = (bf16*)(ws + WS_GA);
    F.ACT = (bf16*)(ws + WS_ACT); F.Gb = (bf16*)(ws + WS_G); F.YSSM = (bf16*)(ws + WS_YSSM); F.HNM = (bf16*)(ws + WS_HNM); F.UM = (bf16*)(ws + WS_UM); F.PS = (float*)(ws + WS_PS);
    F.KM = (bf16*)(ws + WS_KM); F.W8 = (bf16*)(ws + WS_W8); F.G8 = (bf16*)(ws + WS_G8); F.SSMF = (float*)(ws + WS_SSMF);
    for (int u = F.tid; u < (LDS_BYTES - LDSCTL_OFF) / 4; u += NWAVES * 64) ((LAS unsigned*)(F.lds + LDSCTL_OFF))[u] = 0u;
    __syncthreads();
    XcdBarrier bar; bar.bar = (unsigned*)(F.ctl + CW_BAR); bar.x = 0; bar.st = nullptr;
    if (N_LAUNCHES == 1) bar = xcd_barrier_post((unsigned*)(F.ctl + CW_BAR), F.MISC + 8);
#define GRID_BAR(seam) do { if (N_LAUNCHES != 1) { if (F.tid == 0) __hip_atomic_store(F.ctl + CW_TMO, 0xBADBA0u | (unsigned)(seam), RLX_AGENT); } else { xcd_barrier(bar); } } while (0)
    const int lo = args.ph_lo, hi = args.ph_hi;
#define IN(k) (lo <= (k) && (k) < hi)
#define BOTH(k) (IN(k) && IN((k) + 1))
    using namespace pg8;
#define PHASE_0() do { const int g3_ = ((int)blockIdx.x >> 3) % 3; if (g3_ == 0) ssm::p0_tables(F); p0_prologue(F, 1); if (g3_ == 1) ssm::p0_tables(F); p0_prologue(F, 2); if (g3_ == 2) ssm::p0_tables(F); } while (0)
#define PHASE_1() do { \
        Gemm g{F.HN, F.WinT, M, D_IN, D}; StaticOrder S; S.init(M, D_IN, F.G, (int)blockIdx.x); \
        EpiInProj E{F.U, F.Q, F.K, F.V, F.GS, F.GA, F.in[I_QG], F.in[I_KG]}; \
        gemm_phase<EpiInProj, StaticOrder, PG8_ALIGN, PG8_SP2>(F.lds + RING_OFF, g, S, E); if (F.tid == 0) (void)__hip_atomic_fetch_add(F.ctl + CW_ARR1, 1u, RLX_AGENT); meta_proj(F); pull_rest_items(F, 1); } while (0)
#define PHASE_2() do { const int g3_ = ((int)blockIdx.x >> 3) % 3; if (g3_ == 0) pull_rest_half(F, 1u, 3u); att::attn_phase(F, F.Q); if (g3_ == 1) pull_rest_half(F, 1u, 2u); ssm::ssm_phase(F); pull_rest_items(F, 0); } while (0)
#define PHASE_3() do { \
        { Gemm g{F.Gb, F.WgluT, M, D_SSM, D_SSM}; StaticOrder S; S.init(M, D_SSM, F.G, (int)blockIdx.x); \
          EpiGlu E{F.Gb, F.in[I_BGLU], F.YSSM}; \
          gemm_phase<EpiGlu, StaticOrder, PG8_ALIGN, PG8_SP2>(F.lds + RING_OFF, g, S, E); } \
        { Gemm g{F.Q, F.WbrbT, M, D, DATT}; StaticOrder S; S.init(M, D, F.G, (int)blockIdx.x); \
          EpiBranch<true> E{F.GA, F.TM}; \
          gemm_phase<EpiBranch<true>, StaticOrder, PG8_ALIGN, PG8_SP2>(F.lds + RING_OFF, g, S, E); } } while (0)
#define PHASE_4() do { Gemm g{F.YSSM, F.WbraT, M, D, D_SSM}; StaticOrder S; S.init(M, D, F.G, (int)blockIdx.x); \
        EpiBranch<false> E{F.GS, F.TM}; \
        gemm_phase<EpiBranch<false>, StaticOrder, PG8_ALIGN, PG8_SP2>(F.lds + RING_OFF, g, S, E); } while (0)
#define PHASE_5() do { Gemm g{F.TM, F.WoT, M, D, D}; StaticOrder S; S.init(M, D, F.G, (int)blockIdx.x); \
        EpiOut E{F.in[I_X], F.HN, F.PS}; \
        gemm_phase<EpiOut, StaticOrder, PG8_ALIGN, PG8_SP2>(F.lds + RING_OFF, g, S, E); } while (0)
#define PHASE_6() do { Gemm g{F.HN, F.WguT, M, 2 * D_FF, D}; TailOrder S; S.init(M, 2 * D_FF, F.G, (int)blockIdx.x); \
        S.q = (unsigned*)(F.ctl + CW_QTAIL); S.slot = (volatile PG8_LAS unsigned*)(F.MISC + 15); S.tail = S.nwg / F.G; \
        EpiGateUp E{F.PS, F.ACT}; \
        gemm_phase<EpiGateUp, TailOrder, PG8_ALIGN, PG8_SP2>(F.lds + RING_OFF, g, S, E); \
        pull_wdown_items(F); } while (0)
#define PHASE_7() do { Gemm g{F.ACT, F.WdnT, M, D, D_FF}; ARowOnceOrder S; S.init(M, D, F.G, (int)blockIdx.x); \
        EpiDown E{F.HN, F.out}; \
        gemm_phase<EpiDown, ARowOnceOrder, PG8_ALIGN, PG8_SP2>(F.lds + RING_OFF, g, S, E); } while (0)
#ifndef PROBE_CLOCK
#define PROBE_CLOCK 0
#endif
#ifndef PROBE_REP
#define PROBE_REP 0
#endif
    if (IN(0)) { PHASE_0(); if (PROBE_REP & 1) { GRID_BAR(0); PHASE_0(); } if (BOTH(0)) GRID_BAR(0); }
    if (IN(1)) { PHASE_1(); if (PROBE_REP & 2) { GRID_BAR(1); PHASE_1(); } if (BOTH(1)) GRID_BAR(1); }
    if (IN(2)) { PHASE_2(); if (PROBE_REP & 256) { ssm::ssm_phase(F); } if (PROBE_REP & 4) { GRID_BAR(2); PHASE_1(); GRID_BAR(2); PHASE_2(); } if (BOTH(2)) GRID_BAR(2); }
    if (IN(3)) { PHASE_3(); if (PROBE_REP & 8) { GRID_BAR(3); PHASE_3(); } if (BOTH(3)) GRID_BAR(3); }
    if (IN(4)) { PHASE_4(); if (PROBE_REP & 16) { GRID_BAR(4); PHASE_3(); GRID_BAR(4); PHASE_4(); } if (BOTH(4)) GRID_BAR(4); }
    if (IN(5) && (PROBE_REP & 2048)) { GRID_BAR(5); GRID_BAR(5); GRID_BAR(5); GRID_BAR(5); GRID_BAR(5); GRID_BAR(5); GRID_BAR(5); GRID_BAR(5); }
    if (IN(5) && (PROBE_REP & 1024)) { Gemm g{F.TM, F.WoT, M, D, D}; StaticOrder S; S.init(M, D, F.G, (int)blockIdx.x);
        EpiOut E{F.in[I_X], F.HN, F.PS};
        gemm_phase<EpiOut, StaticOrder, PG8_ALIGN, PG8_SP2, true>(F.lds + RING_OFF, g, S, E); GRID_BAR(5); }
    if (IN(5)) { PHASE_5(); if (PROBE_REP & 32) { GRID_BAR(5); PHASE_5(); } if (BOTH(5)) GRID_BAR(5); }
#if PROBE_CLOCK
    long long pc0_ = 0; unsigned long long pr0_ = 0;
    if (IN(6)) { pc0_ = clock64(); pr0_ = __builtin_amdgcn_s_memrealtime(); }
#endif
    if (IN(6)) { PHASE_6(); if (PROBE_REP & 64) { GRID_BAR(6); PHASE_5(); GRID_BAR(6); PHASE_6(); } if (BOTH(6)) GRID_BAR(6); }
#if PROBE_CLOCK
    if (IN(6) && blockIdx.x == 0 && F.tid == 0) { const long long dc_ = clock64() - pc0_; const unsigned long long dr_ = __builtin_amdgcn_s_memrealtime() - pr0_;
        F.ctl[CW_CODE + 8] = (unsigned)((double)dc_ * 100.0 / (double)dr_); }
#endif
    if (IN(7)) { PHASE_7(); if (PROBE_REP & 128) { GRID_BAR(7); PHASE_5(); GRID_BAR(7); PHASE_6(); GRID_BAR(7); PHASE_7(); } }
#if PROBE_CLOCK
    if (IN(7)) { GRID_BAR(7); if (blockIdx.x == 0 && F.tid == 0) { const unsigned mhz_ = __hip_atomic_load(F.ctl + CW_CODE + 8, RLX_AGENT); F.out[0] += (float)((int)mhz_ - PROBE_CLOCK); } }
#endif
#undef IN
#undef BOTH
}

extern "C" void kernel_launch(void* const* d_in, const int* in_sizes, int n_in, void* d_out, int out_size, void* d_ws, size_t ws_size, hipStream_t stream) {
    static int grid = 0;
    if (grid == 0) {
        if (n_in != 27 || in_sizes[0] != M * D || out_size != M * D || ws_size < WS_END) { fprintf(stderr, "kernel_launch: built for 27 inputs, x and out of %d floats, >= %zu bytes of workspace; got n_in %d, in0 %d, out %d, ws %zu; nothing launched\n", M * D, (size_t)WS_END, n_in, n_in > 0 ? in_sizes[0] : -1, out_size, ws_size); grid = -1; return; }
        int dev = 0, cus = 0, per_cu = 0;
        if (hipGetDevice(&dev) != hipSuccess || hipDeviceGetAttribute(&cus, hipDeviceAttributeMultiprocessorCount, dev) != hipSuccess) { fprintf(stderr, "kernel_launch: hipGetDevice / hipDeviceGetAttribute failed; nothing launched\n"); grid = -1; return; }
        if (hipFuncSetAttribute((const void*)mk_fwd, hipFuncAttributeMaxDynamicSharedMemorySize, LDS_BYTES) != hipSuccess) { fprintf(stderr, "kernel_launch: hipFuncSetAttribute failed; nothing launched\n"); grid = -1; return; }
        if (hipOccupancyMaxActiveBlocksPerMultiprocessor(&per_cu, (const void*)mk_fwd, NWAVES * 64, LDS_BYTES) != hipSuccess || per_cu < 1)
            fprintf(stderr, "kernel_launch: note: the occupancy query reports %d workgroups per CU\n", per_cu);
        (void)hipGetLastError();
        grid = cus;
    }
    if (grid < 0) return;
    if (hipMemsetAsync((char*)d_ws + WS_CTL, 0, CTL_ZERO_BYTES, stream) != hipSuccess) { fprintf(stderr, "kernel_launch: hipMemsetAsync of the control words failed; nothing launched\n"); return; }
    Args a{};
    for (int i = 0; i < 27; ++i) a.in[i] = (const float*)d_in[i];
    a.out = (float*)d_out; a.ws = (unsigned char*)d_ws;
    for (int li = 0; li < N_LAUNCHES; ++li) {
        a.ph_lo = (N_LAUNCHES == 1) ? 0 : li; a.ph_hi = (N_LAUNCHES == 1) ? N_PHASES : li + 1; a.li = li;
        hipLaunchKernelGGL(mk_fwd, dim3(grid), dim3(NWAVES * 64), LDS_BYTES, stream, a);
        const hipError_t le = hipPeekAtLastError();
        if (le != hipSuccess) { fprintf(stderr, "kernel_launch: launch %d failed: %s (grid %d x %d threads, %d B LDS)\n", li, hipGetErrorName(le), grid, NWAVES * 64, LDS_BYTES); break; }
    }
}
```

```cpp
#include <hip/hip_runtime.h>
#include <hip/hip_bf16.h>
#include <cstdio>
#include <cstdint>
#include <cmath>
namespace pg8 {
#define PG8_LAS __attribute__((address_space(3)))
typedef unsigned short bf16_t;
typedef short bf16x8 __attribute__((ext_vector_type(8)));
typedef float f32x4 __attribute__((ext_vector_type(4)));
typedef unsigned u32x4 __attribute__((ext_vector_type(4)));
constexpr int BM = 256, BK = 64, HALF = 128, HTB = HALF * BK * 2  , STAGE_BYTES = 8 * HTB, NXCD = 8, WGM = 8;

__host__ __device__ __forceinline__ int lds_byte(int r, int c) { const int st = (r >> 4) * 2 + (c >> 5), rr = r & 15, cc = c & 31, ob = rr * 64 + cc * 2; return st * 1024 + (ob ^ (((ob >> 9) & 1) << 5)); }
__host__ __device__ __forceinline__ void stage_rc(int b, int& R, int& C) { const int st = b / 1024, sb = b % 1024, swz = sb ^ (((sb >> 9) & 1) << 5); R = (st >> 1) * 16 + swz / 64; C = (st & 1) * 32 + (swz % 64) / 2; }
__host__ __device__ __forceinline__ int perm32(int rho) { const int n = rho >> 4, i = rho & 15; return 8 * (i >> 2) + 4 * n + (i & 3); }

struct Unit { int pm, pn; };
struct Gemm { const bf16_t* A; const bf16_t* Bt; int M, N, K; };

struct StaticOrder {
    int nM, nN, nwg, G, c;
    __host__ __device__ void init(int M, int N, int G_, int c_) { nM = M / BM; nN = N / BM; nwg = nM * nN; G = G_; c = c_; }
    __host__ __device__ bool next(int i, Unit& u) const {
        const long L = (long)i * G + c; if (L >= nwg) return false;
        int wgid = (int)L; { const int q = nwg / NXCD, r = nwg % NXCD, xcd = wgid % NXCD, off = wgid / NXCD; wgid = (xcd < r ? xcd * (q + 1) : r * (q + 1) + (xcd - r) * q) + off; }
        const int nig = WGM * nN, gid = wgid / nig, fm = gid * WGM, gsz = (nM - fm) < WGM ? (nM - fm) : WGM;
        u.pm = fm + ((wgid % nig) % gsz); u.pn = (wgid % nig) / gsz; return true;
    }
    __device__ __forceinline__ void a_ready(const Unit&) const {}
    __device__ __forceinline__ void done(const Unit&) const {}
};
struct ARowOnceOrder {
    int G, c;
    __host__ __device__ void init(int, int, int G_, int c_) { G = G_; c = c_; }
    __host__ __device__ bool next(int i, Unit& u) const {
        if (G != 256 || i >= 4) { if (G == 256) return false; const long L = (long)i * G + c; if (L >= 64 * 16) return false; u.pm = (int)(L >> 4); u.pn = (int)(L & 15); return true; }
        const int x = c & 7, j = c >> 3;
        u.pm = 16 * i + 4 * (x >> 1) + (j >> 3); u.pn = 8 * (x & 1) + (j & 7); return true;
    }
    __device__ __forceinline__ void a_ready(const Unit&) const {}
    __device__ __forceinline__ void done(const Unit&) const {}
};
struct TailOrder : StaticOrder {
    unsigned* q; volatile PG8_LAS unsigned* slot; int tail;
    __device__ __forceinline__ bool next(int i, Unit& u) const {
        if (i < tail) return StaticOrder::next(i, u);
        if (i > tail) return false;
        if (threadIdx.x == 0) { const unsigned k = __hip_atomic_fetch_add(q, 1u, __ATOMIC_RELAXED, __HIP_MEMORY_SCOPE_AGENT); *slot = k; }
        asm volatile("s_waitcnt lgkmcnt(0)" ::: "memory"); __builtin_amdgcn_s_barrier(); asm volatile("" ::: "memory");
        const long L = (long)tail * G + (long)*slot; if (L >= nwg) return false;
        int wgid = (int)L; { const int qq = nwg / NXCD, r = nwg % NXCD, xcd = wgid % NXCD, off = wgid / NXCD; wgid = (xcd < r ? xcd * (qq + 1) : r * (qq + 1) + (xcd - r) * qq) + off; }
        const int nig = WGM * nN, gid = wgid / nig, fm = gid * WGM, gsz = (nM - fm) < WGM ? (nM - fm) : WGM;
        u.pm = fm + ((wgid % nig) % gsz); u.pn = (wgid % nig) / gsz; return true;
    }
};

__device__ __forceinline__ unsigned cvt_pk_bf16(float lo, float hi) { unsigned r; asm volatile("v_cvt_pk_bf16_f32 %0, %1, %2" : "=v"(r) : "v"(lo), "v"(hi)); return r; }
typedef float f32x2 __attribute__((ext_vector_type(2)));
constexpr float kEps = 1e-6f;
constexpr float kQScale = 0.125f * 1.4426950408889634f;
__device__ __forceinline__ float sigm(float x) { return __builtin_amdgcn_rcpf(1.0f + __builtin_amdgcn_exp2f(-1.4426950408889634f * x)); }
__device__ __forceinline__ void unpack8(const u32x4 w, float (&f)[8]) {
    f[0] = __uint_as_float(w.x << 16); f[1] = __uint_as_float(w.x & 0xffff0000u); f[2] = __uint_as_float(w.y << 16); f[3] = __uint_as_float(w.y & 0xffff0000u);
    f[4] = __uint_as_float(w.z << 16); f[5] = __uint_as_float(w.z & 0xffff0000u); f[6] = __uint_as_float(w.w << 16); f[7] = __uint_as_float(w.w & 0xffff0000u);
}
__device__ __forceinline__ u32x4 pack8(const f32x4 a, const f32x4 b) { u32x4 w; w.x = cvt_pk_bf16(a[0], a[1]); w.y = cvt_pk_bf16(a[2], a[3]); w.z = cvt_pk_bf16(b[0], b[1]); w.w = cvt_pk_bf16(b[2], b[3]); return w; }
#define EPI_FENCE() asm volatile("" ::: "memory")

struct EpiInProj {
    static constexpr bool PERM = true, AFTER_DRAIN = false;
    bf16_t *U, *Q, *K, *V, *GS, *GA; const float *qg, *kg;
    __device__ __forceinline__ void operator()(const f32x4 (&acc)[2][2][4][2], const Unit& u, int wr, int wc, int fr, int fq) const {
        const int pn = u.pn; const int row0 = u.pm * BM + wr * 64 + fr;
        const int kvoff = 64 * (u.pm / 16 + 1);
        if (pn >= 4 && pn < 20) {
            const bool isq = pn < 12; const int tile = isq ? pn - 4 : pn - 12;
            bf16_t* base = isq ? Q : K; const float* g = isq ? qg : kg; const float sc = isq ? kQScale : 1.0f; const int roff = isq ? 0 : kvoff;
            f32x4 gv[2][2];
#pragma unroll
            for (int bj = 0; bj < 2; ++bj)
#pragma unroll
                for (int n = 0; n < 2; ++n) gv[bj][n] = *(const f32x4*)(g + 32 * bj + 8 * fq + 4 * n) * sc;
#pragma unroll
            for (int ai = 0; ai < 2; ++ai)
#pragma unroll
                for (int m = 0; m < 4; ++m) {
                    float ss = 0.f;
#pragma unroll
                    for (int bj = 0; bj < 2; ++bj)
#pragma unroll
                        for (int n = 0; n < 2; ++n) { const f32x4 x = acc[ai][bj][m][n]; ss += (x[0] * x[0] + x[1] * x[1]) + (x[2] * x[2] + x[3] * x[3]); }
                    ss += __shfl_xor(ss, 16); ss += __shfl_xor(ss, 32);
                    const float rstd = __builtin_amdgcn_rsqf(ss * (1.0f / 64.0f) + kEps);
                    bf16_t* rowp = base + (size_t)(row0 + ai * HALF + m * 16 + roff) * 2048 + tile * 256 + 64 * wc + 8 * fq;
#pragma unroll
                    for (int bj = 0; bj < 2; ++bj) *(u32x4*)(rowp + 32 * bj) = pack8(acc[ai][bj][m][0] * rstd * gv[bj][0], acc[ai][bj][m][1] * rstd * gv[bj][1]);
                }
            return;
        }
        bf16_t* base; int ldc, colt, roff = 0; bool sg = false;
        if (pn < 4) { base = U; ldc = 1024; colt = pn * BM; }
        else if (pn < 28) { base = V; ldc = 2048; colt = (pn - 20) * BM; roff = kvoff; }
        else if (pn < 44) { base = GS; ldc = 4096; colt = (pn - 28) * BM; sg = true; }
        else { base = GA; ldc = 4096; colt = (pn - 44) * BM; sg = true; }
        const int col0 = colt + wc * 32 + 8 * fq;
#pragma unroll
        for (int ai = 0; ai < 2; ++ai)
#pragma unroll
            for (int m = 0; m < 4; ++m) { bf16_t* rowp = base + (size_t)(row0 + ai * HALF + m * 16 + roff) * ldc + col0;
#pragma unroll
                for (int bj = 0; bj < 2; ++bj) { f32x4 v0 = acc[ai][bj][m][0], v1 = acc[ai][bj][m][1];
                    if (sg) {
#pragma unroll
                        for (int e = 0; e < 4; ++e) { v0[e] = sigm(v0[e]); v1[e] = sigm(v1[e]); } }
                    *(u32x4*)(rowp + bj * HALF) = pack8(v0, v1); } }
    }
};
struct EpiGlu {
    static constexpr bool PERM = true, AFTER_DRAIN = false;
    const bf16_t* G; const float* bias; bf16_t* Y;
    __device__ __forceinline__ void operator()(const f32x4 (&acc)[2][2][4][2], const Unit& u, int wr, int wc, int fr, int fq) const {
        const int row0 = u.pm * BM + wr * 64 + fr, col0 = u.pn * BM + wc * 32 + 8 * fq;
        f32x4 bv[2][2];
#pragma unroll
        for (int bj = 0; bj < 2; ++bj)
#pragma unroll
            for (int n = 0; n < 2; ++n) bv[bj][n] = *(const f32x4*)(bias + col0 + bj * HALF + 4 * n);
#pragma unroll
        for (int ai = 0; ai < 2; ++ai)
#pragma unroll
            for (int m = 0; m < 4; ++m) { const size_t off = (size_t)(row0 + ai * HALF + m * 16) * 1024 + col0;
#pragma unroll
                for (int bj = 0; bj < 2; ++bj) { float g[8]; unpack8(*(const u32x4*)(G + off + bj * HALF), g);
                    f32x4 v0 = acc[ai][bj][m][0] + bv[bj][0], v1 = acc[ai][bj][m][1] + bv[bj][1];
#pragma unroll
                    for (int e = 0; e < 4; ++e) { v0[e] = g[e] * sigm(v0[e]); v1[e] = g[4 + e] * sigm(v1[e]); }
                    *(u32x4*)(Y + off + bj * HALF) = pack8(v0, v1); }
                EPI_FENCE(); }
    }
};
template <bool FIRST> struct EpiBranch {
    static constexpr bool PERM = true, AFTER_DRAIN = false;
    const bf16_t* GATE; bf16_t* T;
    __device__ __forceinline__ void operator()(const f32x4 (&acc)[2][2][4][2], const Unit& u, int wr, int wc, int fr, int fq) const {
        const int row0 = u.pm * BM + wr * 64 + fr, col0 = u.pn * BM + wc * 32 + 8 * fq;
#pragma unroll
        for (int ai = 0; ai < 2; ++ai)
#pragma unroll
            for (int m = 0; m < 4; ++m) { const size_t off = (size_t)(row0 + ai * HALF + m * 16) * 4096 + col0;
#pragma unroll
                for (int bj = 0; bj < 2; ++bj) { float g[8]; unpack8(*(const u32x4*)(GATE + off + bj * HALF), g);
                    f32x4 v0 = acc[ai][bj][m][0], v1 = acc[ai][bj][m][1];
                    if (FIRST) {
#pragma unroll
                        for (int e = 0; e < 4; ++e) { v0[e] *= g[e]; v1[e] *= g[4 + e]; }
                    } else { float t[8]; unpack8(*(const u32x4*)(T + off + bj * HALF), t);
#pragma unroll
                        for (int e = 0; e < 4; ++e) { v0[e] = t[e] + v0[e] * g[e]; v1[e] = t[4 + e] + v1[e] * g[4 + e]; } }
                    *(u32x4*)(T + off + bj * HALF) = pack8(v0, v1); }
                EPI_FENCE(); }
    }
};
struct EpiOut {
    static constexpr bool PERM = true, AFTER_DRAIN = false;
    const float* X; bf16_t* HB; float* PS;
    __device__ __forceinline__ void operator()(const f32x4 (&acc)[2][2][4][2], const Unit& u, int wr, int wc, int fr, int fq) const {
        const int row0 = u.pm * BM + wr * 64 + fr, col0 = u.pn * BM + wc * 32 + 8 * fq;
#pragma unroll
        for (int ai = 0; ai < 2; ++ai)
#pragma unroll
            for (int m = 0; m < 4; ++m) { const int row = row0 + ai * HALF + m * 16; const size_t off = (size_t)row * 4096 + col0; float ss = 0.f;
#pragma unroll
                for (int bj = 0; bj < 2; ++bj) { const f32x4 x0 = *(const f32x4*)(X + off + bj * HALF), x1 = *(const f32x4*)(X + off + bj * HALF + 4);
                    const f32x4 v0 = acc[ai][bj][m][0] + x0, v1 = acc[ai][bj][m][1] + x1;
                    ss += (v0[0] * v0[0] + v0[1] * v0[1]) + (v0[2] * v0[2] + v0[3] * v0[3]) + (v1[0] * v1[0] + v1[1] * v1[1]) + (v1[2] * v1[2] + v1[3] * v1[3]);
                    *(u32x4*)(HB + off + bj * HALF) = pack8(v0, v1); }
                ss += __shfl_xor(ss, 16); ss += __shfl_xor(ss, 32);
                if (fq == 0) PS[(size_t)row * 64 + u.pn * 4 + wc] = ss;
                EPI_FENCE(); }
    }
};
struct EpiGateUp {
    static constexpr bool PERM = true, AFTER_DRAIN = false;
    const float* PS; bf16_t* ACT;
    __device__ __forceinline__ void operator()(const f32x4 (&acc)[2][2][4][2], const Unit& u, int wr, int wc, int fr, int fq) const {
        const int row0 = u.pm * BM + wr * 64 + fr, col0 = u.pn * HALF + wc * 32 + 8 * fq;
#pragma unroll
        for (int ai = 0; ai < 2; ++ai)
#pragma unroll
            for (int m = 0; m < 4; ++m) { const int row = row0 + ai * HALF + m * 16;
                const f32x4* ps = (const f32x4*)(PS + (size_t)row * 64 + fq * 16);
                const f32x4 p0 = ps[0], p1 = ps[1], p2 = ps[2], p3 = ps[3];
                float ss = ((p0[0] + p0[1]) + (p0[2] + p0[3])) + ((p1[0] + p1[1]) + (p1[2] + p1[3])) + ((p2[0] + p2[1]) + (p2[2] + p2[3])) + ((p3[0] + p3[1]) + (p3[2] + p3[3]));
                ss += __shfl_xor(ss, 16); ss += __shfl_xor(ss, 32);
                const float r = __builtin_amdgcn_rsqf(ss * (1.0f / 4096.0f) + kEps);
                f32x4 v0, v1;
#pragma unroll
                for (int e = 0; e < 4; ++e) { const float g0 = acc[ai][0][m][0][e] * r, u0 = acc[ai][1][m][0][e] * r, g1 = acc[ai][0][m][1][e] * r, u1 = acc[ai][1][m][1][e] * r;
                    v0[e] = g0 * sigm(g0) * u0; v1[e] = g1 * sigm(g1) * u1; }
                *(u32x4*)(ACT + (size_t)row * 11008 + col0) = pack8(v0, v1);
                EPI_FENCE(); }
    }
};
struct EpiDown {
    static constexpr bool PERM = true, AFTER_DRAIN = false;
    const bf16_t* HB; float* OUT;
    __device__ __forceinline__ void operator()(const f32x4 (&acc)[2][2][4][2], const Unit& u, int wr, int wc, int fr, int fq) const {
        const int row0 = u.pm * BM + wr * 64 + fr, col0 = u.pn * BM + wc * 32 + 8 * fq;
#pragma unroll
        for (int ai = 0; ai < 2; ++ai)
#pragma unroll
            for (int m = 0; m < 4; ++m) { const size_t off = (size_t)(row0 + ai * HALF + m * 16) * 4096 + col0;
#pragma unroll
                for (int bj = 0; bj < 2; ++bj) { float h[8]; unpack8(*(const u32x4*)(HB + off + bj * HALF), h); f32x4* p = (f32x4*)(OUT + off + bj * HALF);
                    p[0] = acc[ai][bj][m][0] + (f32x4){h[0], h[1], h[2], h[3]}; p[1] = acc[ai][bj][m][1] + (f32x4){h[4], h[5], h[6], h[7]}; }
                EPI_FENCE(); }
    }
};
template <class Epi, class Sched, bool ALIGN_EPI = false, bool SP2 = false, bool PLOCAL = false>
__device__ __forceinline__ void gemm_phase(PG8_LAS unsigned char* lds, const Gemm g, const Sched& S, const Epi& E) {
    const int tid = threadIdx.x, wid = __builtin_amdgcn_readfirstlane(tid >> 6), lane = tid & 63, wr = wid >> 2, wc = wid & 3, fr = lane & 15, fq = lane >> 4;
    const int K = g.K, nt = K / BK;
    unsigned voffA[2], voffB[2];
#pragma unroll
    for (int i = 0; i < 2; ++i) { int R, C; stage_rc(tid * 16 + i * 8192, R, C); const int Rb = Epi::PERM ? ((R & ~31) + perm32(R & 31)) : R;
        voffA[i] = (unsigned)(R * K + C) * 2u; voffB[i] = (unsigned)(Rb * K + C) * 2u; }
    const size_t kstep = (size_t)(BK * 2);
    const size_t hstep = (size_t)HALF * K * 2;
    const size_t tstep = 2 * hstep;
    const unsigned ldsw = (unsigned)wid * 1024u;
    const int aoff = lds_byte(wr * 64 + fr, fq * 8), boff = lds_byte(wc * 32 + fr, fq * 8);
#define PG8_SA(b, h) (((b) * 2 + (h)) * HTB)
#define PG8_SB(b, h) ((4 + (b) * 2 + (h)) * HTB)
#define PG8_STAGE(bufoff, gbase, voff) do { _Pragma("unroll") for (int _i = 0; _i < 2; ++_i) \
        __builtin_amdgcn_global_load_lds((const unsigned*)((const char*)(gbase) + (voff)[_i]), (PG8_LAS unsigned*)(lds + (bufoff) + ldsw + _i * 8192), 16, 0, 0); } while (0)
#define PG8_LDA(dst, b, h) do { _Pragma("unroll") for (int m = 0; m < 4; ++m) _Pragma("unroll") for (int k = 0; k < 2; ++k) dst[m][k] = *(const PG8_LAS bf16x8*)(lds + PG8_SA(b, h) + aoff + m * 2048 + k * 1024); } while (0)
#define PG8_LDB(dst, b, h) do { _Pragma("unroll") for (int n = 0; n < 2; ++n) _Pragma("unroll") for (int k = 0; k < 2; ++k) dst[n][k] = *(const PG8_LAS bf16x8*)(lds + PG8_SB(b, h) + boff + n * 2048 + k * 1024); } while (0)
#define PG8_MMA(ai, bj, At, Bt) do { __builtin_amdgcn_s_setprio(1); _Pragma("unroll") for (int m = 0; m < 4; ++m) _Pragma("unroll") for (int n = 0; n < 2; ++n) _Pragma("unroll") for (int k = 0; k < 2; ++k) \
        acc[ai][bj][m][n] = __builtin_amdgcn_mfma_f32_16x16x32_bf16(Bt[n][k], At[m][k], acc[ai][bj][m][n], 0, 0, 0); __builtin_amdgcn_s_setprio(0); } while (0)
#define PG8_WAIT_V(n) asm volatile("s_waitcnt vmcnt(" #n ")" ::: "memory")
#define PG8_WAIT_L(n) asm volatile("s_waitcnt lgkmcnt(" #n ")" ::: "memory")
#define PG8_BAR __builtin_amdgcn_s_barrier()
#define PG8_SCHED __builtin_amdgcn_sched_barrier(0)
    Unit cur, nxt; int ui = 0;
    if (!S.next(0, cur)) return;
    f32x4 acc[2][2][4][2];
#pragma unroll
    for (int a = 0; a < 2; ++a)
#pragma unroll
        for (int b = 0; b < 2; ++b)
#pragma unroll
            for (int m = 0; m < 4; ++m)
#pragma unroll
                for (int n = 0; n < 2; ++n) acc[a][b][m][n] = (f32x4){0.f, 0.f, 0.f, 0.f};
    bf16x8 At[4][2], B0[2][2], B1[2][2];
    const char* cA = (const char*)g.A + (size_t)(PLOCAL ? 0 : cur.pm) * tstep; const char* cB = (const char*)g.Bt + (size_t)(PLOCAL ? 0 : cur.pn) * tstep;
    S.a_ready(cur);
    if constexpr (SP2) {
        PG8_STAGE(PG8_SB(0, 0), cB, voffB); PG8_STAGE(PG8_SB(0, 1), cB + hstep, voffB); PG8_STAGE(PG8_SA(0, 0), cA, voffA); PG8_STAGE(PG8_SA(0, 1), cA + hstep, voffA);
        if (wr == 1) PG8_BAR;
        PG8_WAIT_V(2); PG8_BAR;
        PG8_STAGE(PG8_SB(1, 0), cB + kstep, voffB); PG8_STAGE(PG8_SA(1, 0), cA + kstep, voffA); PG8_STAGE(PG8_SB(1, 1), cB + hstep + kstep, voffB);
        PG8_WAIT_V(6); PG8_BAR;
    } else {
        PG8_STAGE(PG8_SB(0, 0), cB, voffB); PG8_STAGE(PG8_SA(0, 0), cA, voffA); PG8_STAGE(PG8_SB(0, 1), cB + hstep, voffB); PG8_STAGE(PG8_SA(0, 1), cA + hstep, voffA);
        if (wr == 1) PG8_BAR;
        PG8_WAIT_V(4); PG8_BAR;
        PG8_STAGE(PG8_SB(1, 0), cB + kstep, voffB); PG8_STAGE(PG8_SA(1, 0), cA + kstep, voffA); PG8_STAGE(PG8_SB(1, 1), cB + hstep + kstep, voffB);
        PG8_WAIT_V(6); PG8_BAR;
    }
    for (;;) {
        const bool has_next = S.next(ui + 1, nxt);
        const char* nA = has_next ? (const char*)g.A + (size_t)(PLOCAL ? 0 : nxt.pm) * tstep : cA; const char* nB = has_next ? (const char*)g.Bt + (size_t)(PLOCAL ? 0 : nxt.pn) * tstep : cB;
        for (int t = 0; t < nt; t += 2) {
            const bool last = (t == nt - 2);
            const char* a1 = cA + (size_t)(t + 1) * kstep;
            const char* a2 = last ? nA : cA + (size_t)(t + 2) * kstep; const char* b2 = last ? nB : cB + (size_t)(t + 2) * kstep;
            const char* a3 = a2 + kstep; const char* b3 = b2 + kstep;
            if (last && has_next) S.a_ready(nxt);
            if constexpr (SP2) {
            PG8_LDB(B0, 0, 0); PG8_LDB(B1, 0, 1); PG8_SCHED; PG8_LDA(At, 0, 0); PG8_STAGE(PG8_SA(1, 1), a1 + hstep, voffA);
            PG8_WAIT_V(8); PG8_WAIT_L(0); PG8_BAR; PG8_MMA(0, 0, At, B0); PG8_MMA(0, 1, At, B1); PG8_BAR; PG8_SCHED;
            PG8_LDA(At, 0, 1); PG8_STAGE(PG8_SB(0, 0), b2, voffB); PG8_STAGE(PG8_SB(0, 1), b2 + hstep, voffB); PG8_STAGE(PG8_SA(0, 0), a2, voffA);
            PG8_WAIT_V(8); PG8_WAIT_L(0); PG8_BAR; PG8_MMA(1, 0, At, B0); PG8_MMA(1, 1, At, B1); PG8_BAR; PG8_SCHED;
            PG8_LDB(B0, 1, 0); PG8_LDB(B1, 1, 1); PG8_SCHED; PG8_LDA(At, 1, 0); PG8_STAGE(PG8_SA(0, 1), a2 + hstep, voffA);
            PG8_WAIT_V(8); PG8_WAIT_L(0); PG8_BAR; PG8_MMA(0, 0, At, B0); PG8_MMA(0, 1, At, B1); PG8_BAR; PG8_SCHED;
            PG8_LDA(At, 1, 1); PG8_STAGE(PG8_SB(1, 0), b3, voffB); PG8_STAGE(PG8_SB(1, 1), b3 + hstep, voffB); PG8_STAGE(PG8_SA(1, 0), a3, voffA);
            PG8_WAIT_V(8); PG8_WAIT_L(0); PG8_BAR; PG8_MMA(1, 0, At, B0); PG8_MMA(1, 1, At, B1); PG8_BAR; PG8_SCHED;
            } else {
            PG8_LDB(B0, 0, 0); PG8_SCHED; PG8_LDA(At, 0, 0); PG8_STAGE(PG8_SA(1, 1), a1 + hstep, voffA);
            PG8_WAIT_L(8); PG8_BAR; PG8_WAIT_L(0); PG8_MMA(0, 0, At, B0); PG8_BAR; PG8_SCHED;
            PG8_LDB(B1, 0, 1); PG8_STAGE(PG8_SB(0, 0), b2, voffB);
            PG8_BAR; PG8_WAIT_L(0); PG8_MMA(0, 1, At, B1); PG8_BAR;
            PG8_LDA(At, 0, 1); PG8_STAGE(PG8_SA(0, 0), a2, voffA);
            PG8_BAR; PG8_WAIT_L(0); PG8_MMA(1, 0, At, B0); PG8_BAR; PG8_SCHED;
            PG8_STAGE(PG8_SB(0, 1), b2 + hstep, voffB);
            PG8_WAIT_V(6); PG8_BAR; PG8_MMA(1, 1, At, B1); PG8_BAR;
            PG8_LDB(B0, 1, 0); PG8_SCHED; PG8_LDA(At, 1, 0); PG8_STAGE(PG8_SA(0, 1), a2 + hstep, voffA);
            PG8_WAIT_L(8); PG8_BAR; PG8_WAIT_L(0); PG8_MMA(0, 0, At, B0); PG8_BAR; PG8_SCHED;
            PG8_LDB(B1, 1, 1); PG8_STAGE(PG8_SB(1, 0), b3, voffB);
            PG8_BAR; PG8_WAIT_L(0); PG8_MMA(0, 1, At, B1); PG8_BAR;
            PG8_LDA(At, 1, 1); PG8_STAGE(PG8_SA(1, 0), a3, voffA);
            PG8_BAR; PG8_WAIT_L(0); PG8_MMA(1, 0, At, B0); PG8_BAR; PG8_SCHED;
            PG8_STAGE(PG8_SB(1, 1), b3 + hstep, voffB);
            PG8_WAIT_V(6); PG8_BAR; PG8_MMA(1, 1, At, B1); PG8_BAR;
            }
        }
        if constexpr (ALIGN_EPI) { if (wr == 0) PG8_BAR; }
        if constexpr (!Epi::AFTER_DRAIN) { E(acc, cur, wr, wc, fr, fq); S.done(cur); }
        if (!has_next) break;
#pragma unroll
        for (int a = 0; a < 2; ++a)
#pragma unroll
            for (int b = 0; b < 2; ++b)
#pragma unroll
                for (int m = 0; m < 4; ++m)
#pragma unroll
                    for (int n = 0; n < 2; ++n) acc[a][b][m][n] = (f32x4){0.f, 0.f, 0.f, 0.f};
        cur = nxt; cA = nA; cB = nB; ++ui;
        if constexpr (ALIGN_EPI) { if (wr == 1) PG8_BAR; }
    }
    PG8_WAIT_V(0);
    if constexpr (!ALIGN_EPI) { if (wr == 0) PG8_BAR; }
    PG8_BAR;
    if constexpr (Epi::AFTER_DRAIN) { E.fused(acc, cur, wr, wc, fr, fq, lds, wid, lane); S.done(cur); }
#undef PG8_SA
#undef PG8_SB
#undef PG8_STAGE
#undef PG8_LDA
#undef PG8_LDB
#undef PG8_MMA
#undef PG8_WAIT_V
#undef PG8_WAIT_L
#undef PG8_BAR
#undef PG8_SCHED
}
}

#ifndef PG8_SP2
#define PG8_SP2 true
#endif
#ifndef PG8_ALIGN
#define PG8_ALIGN true
#endif
constexpr int NWAVES = 8;
#ifndef MK_N_LAUNCHES
#define MK_N_LAUNCHES 1
#endif
constexpr int N_PHASES = 8;
constexpr int N_LAUNCHES = MK_N_LAUNCHES;

constexpr int BATCH = 4, SEQ = 4096, D = 4096, NMETA = 16;
constexpr int M = BATCH * SEQ;
constexpr int D_SSM = 1024, NGRP = 64, SGRP = 16, NSTATE = 64;
constexpr int NH = 16, HD = 64, VD = 128, QKW = 2048, DATT = 2048;
constexpr int D_IN = 15360, D_FF = 11008;
constexpr int KVROWS = SEQ + 64;
constexpr float EPS = 1e-6f;
constexpr float LAMBDA_INIT = 0.2f;
constexpr float LOG2E = 1.4426950408889634f;

constexpr size_t MiB = 1u << 20;
constexpr size_t WS_CTL = 0, CTL_ZERO_BYTES = 1 * MiB;
constexpr size_t WS_WIN = 2 * MiB, WS_WGLU = 122 * MiB, WS_WBRA = 124 * MiB, WS_WBRB = 132 * MiB, WS_WO = 148 * MiB, WS_WGU = 180 * MiB, WS_WDN = 352 * MiB;
constexpr size_t WS_HN = 438 * MiB;
constexpr size_t WS_TM = 566 * MiB;
constexpr size_t WS_U = 694 * MiB, WS_Q = 726 * MiB, WS_K = 790 * MiB, WS_V = 855 * MiB, WS_GS = 920 * MiB, WS_GA = 1048 * MiB;
constexpr size_t WS_ACT = 694 * MiB;
constexpr size_t WS_G = 1176 * MiB, WS_YSSM = 1208 * MiB;
constexpr size_t WS_PS = 1240 * MiB;
constexpr size_t WS_HNM = 1244 * MiB, WS_UM = 1245 * MiB;
constexpr size_t WS_KM = 1246 * MiB, WS_W8 = 1249 * MiB, WS_G8 = 1251 * MiB, WS_SSMF = 1253 * MiB;
constexpr size_t WS_END = 1290 * MiB;
static_assert(WS_WIN + (size_t)D_IN * D * 2 <= WS_WGLU && WS_WGU + (size_t)2 * D_FF * D * 2 <= WS_WDN && WS_WDN + (size_t)D * D_FF * 2 <= WS_HN, "weights map");
static_assert(WS_K + (size_t)BATCH * KVROWS * QKW * 2 <= WS_V && WS_V + (size_t)BATCH * KVROWS * DATT * 2 <= WS_GS && WS_ACT + (size_t)M * D_FF * 2 <= WS_GA, "activation map");
constexpr int CW_TMO = 0, CW_CODE = 1;
constexpr int CW_BAR = 4096;

constexpr int RING_OFF = 0, RING_BYTES = 131072;
constexpr int LDS_BYTES = 147456;
constexpr int BIG_BYTES = LDS_BYTES - 1024;
constexpr int LDSCTL_OFF = BIG_BYTES, MISC_OFF = LDSCTL_OFF + 320;
static_assert(MISC_OFF + 128 <= LDS_BYTES, "LDS map");
#define GAS __attribute__((address_space(1)))
#define LAS __attribute__((address_space(3)))
typedef unsigned short bf16;
typedef unsigned v4u __attribute__((ext_vector_type(4)));
typedef float f32x4 __attribute__((ext_vector_type(4)));
typedef short bf16x8 __attribute__((ext_vector_type(8)));
typedef GAS unsigned gu32;
typedef GAS unsigned long long gu64;
#define RLX_AGENT __ATOMIC_RELAXED, __HIP_MEMORY_SCOPE_AGENT
#define LDS_WAIT() asm volatile("s_waitcnt lgkmcnt(0)" ::: "memory")
#define VM_WAIT() asm volatile("s_waitcnt vmcnt(0)" ::: "memory")
__device__ __forceinline__ unsigned long long rt() { return __builtin_amdgcn_s_memrealtime(); }
__device__ __forceinline__ unsigned f2bf(float f) { unsigned u = __builtin_bit_cast(unsigned, f); return (u + 0x7fffu + ((u >> 16) & 1u)) >> 16; }
__device__ __forceinline__ unsigned pk2(float lo, float hi) { return f2bf(lo) | (f2bf(hi) << 16); }

#define XB_TMO      128
#define XB_XCNT(j)  (256  + 64 * (j))
#define XB_XSUB(j)  (1280 + 64 * (j))
#define XB_XGEN(j)  (2304 + 64 * (j))
#define XB_TOP      3328
#define XB_TOPGEN   3392
#define XCD_BAR_WORDS 3456
#define XB_SPIN_CAP (1u << 18)

__device__ __forceinline__ unsigned xb_ld(unsigned* p)              { return __hip_atomic_load(p, __ATOMIC_RELAXED, __HIP_MEMORY_SCOPE_AGENT); }
__device__ __forceinline__ unsigned xb_add(unsigned* p, unsigned v) { return __hip_atomic_fetch_add(p, v, __ATOMIC_RELAXED, __HIP_MEMORY_SCOPE_AGENT); }
__device__ __forceinline__ unsigned xb_xcc_id() { return (unsigned)__builtin_amdgcn_s_getreg((3 << 11) | 20) & 0xFu; }
#define XB_SPIN(cond, bar) do { unsigned _sp = 0; while (cond) { __builtin_amdgcn_s_sleep(1); \
    if ((++_sp & 255u) == 0u) { if (xb_ld(&(bar)[XB_TMO])) break; if (_sp > XB_SPIN_CAP) { atomicAdd(&(bar)[XB_TMO], 1u); break; } } } } while (0)

struct XcdBarrier {
    unsigned* bar; unsigned x;
    volatile LAS unsigned* st;
};

__device__ __forceinline__ XcdBarrier xcd_barrier_post(unsigned* bar, volatile LAS unsigned* st) {
    XcdBarrier b; b.bar = bar; b.x = xb_xcc_id(); b.st = st;
    if (threadIdx.x == 0) (void)xb_add(&bar[XB_XCNT(b.x)], 1u);
    return b;
}
__device__ __forceinline__ void xcd_barrier_complete(unsigned* bar, unsigned x, unsigned& nloc, unsigned& nx) {
    const unsigned G = gridDim.x * gridDim.y * gridDim.z;
    unsigned sum, cnt, mine, sp = 0u;
    for (;;) {
        sum = 0u; cnt = 0u; mine = 0u;
#pragma unroll
        for (unsigned j = 0; j < 16; ++j) { const unsigned c = xb_ld(&bar[XB_XCNT(j)]); sum += c; cnt += (c > 0u) ? 1u : 0u; mine = (j == x) ? c : mine; }
        if (sum == G) break;
        __builtin_amdgcn_s_sleep(1);
        if ((++sp & 255u) == 0u) { if (xb_ld(&bar[XB_TMO])) break; if (sp > XB_SPIN_CAP) { atomicAdd(&bar[XB_TMO], 1u); break; } }
    }
    nloc = mine > 0u ? mine : 1u; nx = cnt > 0u ? cnt : 1u;
}

__device__ __forceinline__ void xcd_barrier(const XcdBarrier& b) {
    asm volatile("s_waitcnt vmcnt(0)" ::: "memory");
    __syncthreads();
    if (threadIdx.x == 0) {
        unsigned* bar = b.bar;
        __builtin_amdgcn_s_waitcnt(0);
        unsigned nloc = b.st[0], nx = b.st[1];
        if (nloc == 0u) { xcd_barrier_complete(bar, b.x, nloc, nx); b.st[0] = nloc; b.st[1] = nx; }
        const unsigned old = xb_add(&bar[XB_XSUB(b.x)], 1u);
        const unsigned gen = old / nloc;
        if (old + 1u == (gen + 1u) * nloc) {
            __builtin_amdgcn_fence(__ATOMIC_RELEASE, "agent");
            asm volatile("s_waitcnt vmcnt(0)" ::: "memory");
            const unsigned og = xb_add(&bar[XB_TOP], 1u);
            const unsigned tg = og / nx;
            if (og + 1u == (tg + 1u) * nx) xb_add(&bar[XB_TOPGEN], 1u);
            else XB_SPIN(xb_ld(&bar[XB_TOPGEN]) == tg, bar);
            __builtin_amdgcn_fence(__ATOMIC_ACQUIRE, "agent");
            xb_add(&bar[XB_XGEN(b.x)], 1u);
            asm volatile("s_waitcnt vmcnt(0)" ::: "memory");
        } else {
            XB_SPIN(xb_ld(&bar[XB_XGEN(b.x)]) == gen, bar);
            __builtin_amdgcn_fence(__ATOMIC_ACQUIRE, "agent");
            asm volatile("s_waitcnt vmcnt(0)" ::: "memory");
        }
    }
    __syncthreads();
}
struct Frame {
    LAS unsigned char* lds;
    volatile LAS unsigned* MISC;
    gu32* ctl;
    int tid, lane, wave;
    int vcu, G;
    const float* in[27]; float* out; unsigned char* ws;
    bf16 *WinT, *WgluT, *WbraT, *WbrbT, *WoT, *WguT, *WdnT;
    bf16 *HN, *TM, *U, *Q, *K, *V, *GS, *GA, *ACT, *Gb, *YSSM, *HNM, *UM, *KM, *W8, *G8; float *PS, *SSMF;
};
enum { I_X = 0, I_META, I_RELB, I_LN1G, I_WIN, I_QG, I_KG, I_LQ1, I_LK1, I_LQ2, I_LK2, I_SUBG, I_LRE, I_LIM, I_LOGDT, I_BRE, I_BIM, I_CRE, I_CIM, I_DSKIP, I_WGLU, I_BGLU, I_WBR, I_WO, I_LN2G, I_WGU, I_WDN };

__device__ __forceinline__ float wave_sum(float v) {
#pragma unroll
    for (int o = 1; o < 64; o <<= 1) v += __shfl_xor(v, o);
    return v;
}
__device__ __forceinline__ float wave_max(float v) {
#pragma unroll
    for (int o = 1; o < 64; o <<= 1) v = fmaxf(v, __shfl_xor(v, o));
    return v;
}
__device__ __forceinline__ float bf_lo(unsigned w) { return __uint_as_float(w << 16); }
__device__ __forceinline__ float bf_hi(unsigned w) { return __uint_as_float(w & 0xffff0000u); }

enum { RM_ID = 0, RM_IN = 1, RM_GU = 2 };
__device__ __forceinline__ int rowmap(int mode, int n) {
    if (mode == RM_IN) { if (n >= 1024 && n < 5120) { const int base = n - 1024, tile = base >> 8, c = base & 255, w = c >> 6, i = c & 63; return 1024 + tile * 256 + (i >> 5) * 128 + w * 32 + (i & 31); } return n; }
    if (mode == RM_GU) { const int up = n >= D_FF ? 1 : 0; const int j = up ? n - D_FF : n; return (j >> 7) * 256 + up * 128 + (j & 127); }
    return n;
}
__device__ __forceinline__ void p0_transpose_item(const float* W, int K, int N, bf16* WT, int mode, const float* ksc, LAS float* scr, int item, int lane) {
    const int nblk = N / 64, kb = item / nblk, nb = item % nblk, k0 = 64 * kb, n0 = 64 * nb;
    const int kk = lane >> 4, nq = lane & 15;
    f32x4 v[16];
#pragma unroll
    for (int i = 0; i < 16; ++i) v[i] = *(const GAS f32x4*)(W + (size_t)(k0 + 4 * i + kk) * N + n0 + 4 * nq);
    if (ksc) {
#pragma unroll
        for (int i = 0; i < 16; ++i) v[i] = v[i] * ksc[k0 + 4 * i + kk]; }
#pragma unroll
    for (int i = 0; i < 16; ++i) { const int k = 4 * i + kk; *(LAS f32x4*)(scr + k * 64 + 4 * (nq ^ ((k >> 3) & 7))) = v[i]; }
    LDS_WAIT(); asm volatile("" ::: "memory");
    const int c = lane & 7;
#pragma unroll
    for (int j = 0; j < 8; ++j) { const int n = (lane >> 3) + 8 * j; const LAS float* s = scr + (8 * c) * 64 + 4 * ((n >> 2) ^ c) + (n & 3);
        v4u o; o.x = pk2(s[0 * 64], s[1 * 64]); o.y = pk2(s[2 * 64], s[3 * 64]); o.z = pk2(s[4 * 64], s[5 * 64]); o.w = pk2(s[6 * 64], s[7 * 64]);
        *(GAS v4u*)(WT + (size_t)rowmap(mode, n0 + n) * K + k0 + 8 * c) = o; }
    LDS_WAIT(); asm volatile("" ::: "memory");
}
__device__ __forceinline__ void rms_row_to_bf16(const float* xrow, const float* g, bf16* orow, int lane) {
    f32x4 v[8][2]; float s = 0.f;
#pragma unroll
    for (int j = 0; j < 8; ++j) { const GAS f32x4* p = (const GAS f32x4*)(xrow + 512 * j + 8 * lane); v[j][0] = p[0]; v[j][1] = p[1];
        s += ((v[j][0].x * v[j][0].x + v[j][0].y * v[j][0].y) + (v[j][0].z * v[j][0].z + v[j][0].w * v[j][0].w)) + ((v[j][1].x * v[j][1].x + v[j][1].y * v[j][1].y) + (v[j][1].z * v[j][1].z + v[j][1].w * v[j][1].w)); }
    const float r = 1.0f / sqrtf(wave_sum(s) * (1.0f / D) + EPS);
#pragma unroll
    for (int j = 0; j < 8; ++j) { const GAS f32x4* gp = (const GAS f32x4*)(g + 512 * j + 8 * lane); const f32x4 a = v[j][0] * r * gp[0], b = v[j][1] * r * gp[1];
        v4u o; o.x = pk2(a.x, a.y); o.y = pk2(a.z, a.w); o.z = pk2(b.x, b.y); o.w = pk2(b.z, b.w);
        *(GAS v4u*)(orow + 512 * j + 8 * lane) = o; }
}
constexpr int CW_QDN = 2240, CW_QTAIL = 2304;
__device__ __forceinline__ void pull_wdown_items(Frame& F) {
    constexpr int I_DN = (D_FF / 64) * (D / 64);
    LAS float* scr = (LAS float*)(F.lds + RING_OFF + F.wave * 16384);
    volatile LAS unsigned* slot = F.MISC + 14;
    __syncthreads();
    for (;;) {
        if (F.tid == 0) { unsigned idx = __hip_atomic_fetch_add(F.ctl + CW_QDN, 8u, RLX_AGENT); if (idx >= (unsigned)I_DN) idx = 0xffffffffu; *slot = idx; }
        __syncthreads();
        const unsigned idx = *slot;
        if (idx == 0xffffffffu) break;
        const int it = (int)idx + F.wave;
        if (it < I_DN) p0_transpose_item(F.in[I_WDN], D_FF, D, F.WdnT, RM_ID, nullptr, scr, it, F.lane);
        __syncthreads();
    }
    __syncthreads();
}
__device__ __forceinline__ void p0_prologue(Frame& F, int parts) {
    LAS float* scr = (LAS float*)(F.lds + RING_OFF + F.wave * 16384);
    const int gw = F.vcu * NWAVES + F.wave, NGW = F.G * NWAVES;
    constexpr int I_IN = (D / 64) * (D_IN / 64);
    if (parts & 1) for (int it = gw; it < I_IN; it += NGW) p0_transpose_item(F.in[I_WIN], D, D_IN, F.WinT, RM_IN, nullptr, scr, it, F.lane);
    if (parts & 2) for (int m = gw; m < M + NMETA; m += NGW) {
        if (m < M) rms_row_to_bf16(F.in[I_X] + (size_t)m * D, F.in[I_LN1G], F.HN + (size_t)m * D, F.lane);
        else rms_row_to_bf16(F.in[I_META] + (size_t)(m - M) * D, F.in[I_LN1G], F.HNM + (size_t)(m - M) * D, F.lane);
    }
}
constexpr int CW_QITEM = 2048, CW_ARR1 = 2112;
__device__ __forceinline__ void rest_item(Frame& F, LAS float* scr, int r) {
    constexpr int I_GLU = (D_SSM / 64) * (D_SSM / 64), I_BRA = (D_SSM / 64) * (D / 64), I_BRB = (DATT / 64) * (D / 64), I_O = (D / 64) * (D / 64);
    if (r < I_GLU) { p0_transpose_item(F.in[I_WGLU], D_SSM, D_SSM, F.WgluT, RM_ID, nullptr, scr, r, F.lane); return; } r -= I_GLU;
    if (r < I_BRA) { p0_transpose_item(F.in[I_WBR], D_SSM, D, F.WbraT, RM_ID, nullptr, scr, r, F.lane); return; } r -= I_BRA;
    if (r < I_BRB) { p0_transpose_item(F.in[I_WBR] + (size_t)D_SSM * D, DATT, D, F.WbrbT, RM_ID, nullptr, scr, r, F.lane); return; } r -= I_BRB;
    if (r < I_O) { p0_transpose_item(F.in[I_WO], D, D, F.WoT, RM_ID, nullptr, scr, r, F.lane); return; } r -= I_O;
    p0_transpose_item(F.in[I_WGU], D, 2 * D_FF, F.WguT, RM_GU, F.in[I_LN2G], scr, r, F.lane);
}
__device__ __forceinline__ void pull_rest_items(Frame& F, int opportunistic) {
    constexpr int NITEMS = (D_SSM / 64) * (D_SSM / 64) + (D_SSM / 64) * (D / 64) + (DATT / 64) * (D / 64) + (D / 64) * (D / 64) + (D / 64) * (2 * D_FF / 64);
    LAS float* scr = (LAS float*)(F.lds + RING_OFF + F.wave * 16384);
    volatile LAS unsigned* slot = F.MISC + 12;
    __syncthreads();
    for (;;) {
        if (F.tid == 0) { unsigned idx = 0xffffffffu;
            const bool stop = opportunistic && __hip_atomic_load(F.ctl + CW_ARR1, RLX_AGENT) >= (unsigned)F.G;
            if (!stop) { idx = __hip_atomic_fetch_add(F.ctl + CW_QITEM, 8u, RLX_AGENT); if (idx >= (unsigned)NITEMS) idx = 0xffffffffu; }
            *slot = idx; }
        __syncthreads();
        const unsigned idx = *slot;
        if (idx == 0xffffffffu) break;
        const int it = (int)idx + F.wave;
        if (it < NITEMS) rest_item(F, scr, it);
        __syncthreads();
    }
    __syncthreads();
}

__device__ __forceinline__ void pull_rest_half(Frame& F, unsigned num = 1u, unsigned den = 2u) {
    constexpr int NITEMS = (D_SSM / 64) * (D_SSM / 64) + (D_SSM / 64) * (D / 64) + (DATT / 64) * (D / 64) + (D / 64) * (D / 64) + (D / 64) * (2 * D_FF / 64);
    LAS float* scr = (LAS float*)(F.lds + RING_OFF + F.wave * 16384);
    volatile LAS unsigned* slot = F.MISC + 12;
    unsigned target = 0;
    if (F.tid == 0) { const unsigned h0 = __hip_atomic_load(F.ctl + CW_QITEM, RLX_AGENT); target = h0 >= (unsigned)NITEMS ? 0u : h0 + ((unsigned)NITEMS - h0) * num / den; }
    __syncthreads();
    for (;;) {
        if (F.tid == 0) { unsigned idx = 0xffffffffu;
            if (__hip_atomic_load(F.ctl + CW_QITEM, RLX_AGENT) < target) { idx = __hip_atomic_fetch_add(F.ctl + CW_QITEM, 8u, RLX_AGENT); if (idx >= (unsigned)NITEMS) idx = 0xffffffffu; }
            *slot = idx; }
        __syncthreads();
        const unsigned idx = *slot;
        if (idx == 0xffffffffu) break;
        const int it = (int)idx + F.wave;
        if (it < NITEMS) rest_item(F, scr, it);
        __syncthreads();
    }
    __syncthreads();
}

__device__ __forceinline__ void meta_tile(Frame& F, int t) {
        const int lane = F.lane, w = F.wave, l15 = lane & 15, kq = lane >> 4;
        const int type = t < 16 ? 0 : (t < 48 ? 1 : 2), Gi = t - (type == 0 ? 0 : (type == 1 ? 16 : 48));
        const bf16* arow[4];
#pragma unroll
        for (int sb = 0; sb < 4; ++sb) { const int c = 16 * sb + l15;
            const int row = type == 0 ? 64 * Gi + c : (type == 1 ? 3072 + (Gi >> 2) * 256 + (c >> 5) * 128 + (Gi & 3) * 32 + (c & 31) : 5120 + 64 * Gi + c);
            arow[sb] = F.WinT + (size_t)row * D + w * 512 + 8 * kq; }
        const bf16* brow = F.HNM + (size_t)l15 * D + w * 512 + 8 * kq;
        f32x4 acc[4];
#pragma unroll
        for (int sb = 0; sb < 4; ++sb) acc[sb] = (f32x4){0.f, 0.f, 0.f, 0.f};
#pragma unroll 4
        for (int ks = 0; ks < 16; ++ks) { const bf16x8 b = *(const bf16x8*)(brow + 32 * ks);
#pragma unroll
            for (int sb = 0; sb < 4; ++sb) { const bf16x8 a = *(const bf16x8*)(arow[sb] + 32 * ks); acc[sb] = __builtin_amdgcn_mfma_f32_16x16x32_bf16(a, b, acc[sb], 0, 0, 0); } }
        LAS f32x4* part = (LAS f32x4*)(F.lds + RING_OFF);
#pragma unroll
        for (int sb = 0; sb < 4; ++sb) part[(w * 4 + sb) * 64 + lane] = acc[sb];
        __syncthreads();
        if (F.tid < 256) {
            const int j = F.tid >> 4, cq = F.tid & 15, l = j + 16 * (cq & 3), sb = cq >> 2;
            f32x4 v = (f32x4){0.f, 0.f, 0.f, 0.f};
#pragma unroll
            for (int w2 = 0; w2 < 8; ++w2) v += part[(w2 * 4 + sb) * 64 + l];
            if (type == 1) { float ss = (v.x * v.x + v.y * v.y) + (v.z * v.z + v.w * v.w);
                ss += __shfl_xor(ss, 1); ss += __shfl_xor(ss, 2); ss += __shfl_xor(ss, 4); ss += __shfl_xor(ss, 8);
                const float r = 1.0f / sqrtf(ss * (1.0f / 64.0f) + EPS); const f32x4 gn = *(const f32x4*)(F.in[I_KG] + 4 * cq); v = v * r * gn; }
            uint2 o; o.x = pk2(v.x, v.y); o.y = pk2(v.z, v.w);
            if (type == 0) *(uint2*)(F.UM + j * D_SSM + 64 * Gi + 4 * cq) = o;
            else { bf16* base = type == 1 ? F.K : F.V;
#pragma unroll
                for (int b = 0; b < BATCH; ++b) *(uint2*)(base + (size_t)(b * KVROWS + 48 + j) * 2048 + 64 * Gi + 4 * cq) = o; }
        }
    __syncthreads();
}
constexpr int CW_QMETA = 2176;
__device__ __forceinline__ void meta_proj(Frame& F) {
    { const int nth = (int)gridDim.x * NWAVES * 64;
      for (int i = (int)blockIdx.x * NWAVES * 64 + F.tid; i < 2 * BATCH * 48 * 256; i += nth) {
          const int tensor = i / (BATCH * 48 * 256), r = i % (BATCH * 48 * 256), b = r / (48 * 256), rr = (r % (48 * 256)) / 256, ch = r % 256;
          bf16* p = (tensor ? F.V : F.K) + (size_t)(b * KVROWS + rr) * 2048 + ch * 8;
          *(v4u*)p = (v4u){0u, 0u, 0u, 0u}; } }
    volatile LAS unsigned* slot = F.MISC + 13;
    __syncthreads();
    for (;;) {
        if (F.tid == 0) *slot = __hip_atomic_fetch_add(F.ctl + CW_QMETA, 1u, RLX_AGENT);
        __syncthreads();
        const unsigned t = *slot;
        if (t >= 80u) break;
        meta_tile(F, (int)t);
    }
    __syncthreads();
}

__device__ __forceinline__ float gelu_tanh(float x) { const float z = 0.7978845608028654f * (x + 0.044715f * x * x * x); const float e = __expf(2.0f * z); return 0.5f * x * (2.0f - 2.0f / (e + 1.0f)); }
constexpr int BB_LD = 132;
__device__ __forceinline__ float diff_lambda(Frame& F) {
    const float s1 = wave_sum(F.in[I_LQ1][F.lane] * F.in[I_LK1][F.lane]), s2 = wave_sum(F.in[I_LQ2][F.lane] * F.in[I_LK2][F.lane]);
    return expf(s1) - expf(s2) + LAMBDA_INIT;
}
namespace att {
typedef float f32x16 __attribute__((ext_vector_type(16)));
typedef short s16x4 __attribute__((ext_vector_type(4)));
typedef short v4i16_t __attribute__((ext_vector_type(4)));
typedef LAS const char* lds_cptr;
typedef unsigned u32x4 __attribute__((ext_vector_type(4)));
constexpr int SLOT = 16384, NSLOT = 4, L_K = 0, L_V = NSLOT * SLOT, L_BB = 2 * NSLOT * SLOT, L_WS = L_BB + 8704, L_END = L_WS + NWAVES * 256;
constexpr int L_X = 0, L_STG = L_V;
static_assert(NH * BB_LD * 4 <= 8704 && L_END <= BIG_BYTES && 4 * 16384 <= NSLOT * SLOT, "attention LDS map");
__device__ __forceinline__ int crow(int r, int hi) { return (r & 3) + 8 * (r >> 2) + 4 * hi; }
__device__ __forceinline__ void glds16(const void* gsrc, unsigned lds_dst) { unsigned keep;
    asm volatile("s_mov_b32 %0, m0\n\ts_mov_b32 m0, %2\n\ts_nop 0\n\tglobal_load_lds_dwordx4 %1, off\n\ts_mov_b32 m0, %0" : "=&s"(keep) : "v"(gsrc), "s"(lds_dst) : "memory"); }
__device__ __forceinline__ s16x4 vtr(lds_cptr p) { return __builtin_bit_cast(s16x4, __builtin_amdgcn_ds_read_tr16_b64_v4i16((LAS v4i16_t*)p)); }
__device__ __forceinline__ unsigned cvtpk(float lo, float hi) { typedef float f2 __attribute__((ext_vector_type(2))); typedef __bf16 b2 __attribute__((ext_vector_type(2))); f2 v = {lo, hi}; b2 b = __builtin_convertvector(v, b2); return __builtin_bit_cast(unsigned, b); }
#define ATT_WAIT_BAR() asm volatile("s_waitcnt vmcnt(0) lgkmcnt(0)\n\ts_barrier" ::: "memory")

__device__ __forceinline__ void build_rel_bias_table(Frame& F, LAS float* bbt) {
    const float* rb = F.in[I_RELB];
    for (int idx = F.tid; idx < NH * 129; idx += NWAVES * 64) { const int h = idx / 129, d = idx % 129;
        int bucket = d; if (d >= 16) { bucket = 16 + (int)(logf((float)d * (1.0f / 16.0f)) / 2.0794415416798357f * 16.0f); bucket = bucket > 31 ? 31 : bucket; }
        bbt[h * BB_LD + d] = (rb[bucket * NH + h] - rb[31 * NH + h]) * LOG2E; }
    for (int h = F.tid; h < NH; h += NWAVES * 64) bbt[h * BB_LD + 129] = -1e30f;
}
__device__ __forceinline__ void qk_half(f32x16& s, lds_cptr kp, const int (&ko)[4], const bf16x8 (&qr)[4]) {
    const f32x16 z = {0.f, 0.f, 0.f, 0.f, 0.f, 0.f, 0.f, 0.f, 0.f, 0.f, 0.f, 0.f, 0.f, 0.f, 0.f, 0.f};
#pragma unroll
    for (int d0 = 0; d0 < 4; ++d0) { const bf16x8 a = *(const LAS bf16x8*)(kp + ko[d0]); s = __builtin_amdgcn_mfma_f32_32x32x16_bf16(a, qr[d0], d0 == 0 ? z : s, 0, 0, 0); }
}
__device__ __forceinline__ void band_fix(f32x16& s, const LAS float* bb, int dbase, int pos4) {
#pragma unroll
    for (int r = 0; r < 16; ++r) { const int ko = (r & 3) + 8 * (r >> 2);
        const int dist = dbase - ko, pos = pos4 + ko; const bool valid = dist >= 0 && pos >= -NMETA; const int idx = valid ? (dist > 128 ? 128 : dist) : 129;
        s[r] += bb[idx]; }
}
__device__ __forceinline__ void exp_pack(f32x16& s, float& l, u32x4& pa, u32x4& pb) {
    float acc0 = 0.f, acc1 = 0.f;
#pragma unroll
    for (int r = 0; r < 16; ++r) s[r] = __builtin_amdgcn_exp2f(s[r]);
#pragma unroll
    for (int r = 0; r < 16; r += 2) { acc0 += s[r]; acc1 += s[r + 1]; asm("" : "+v"(acc0)); asm("" : "+v"(acc1)); }
    l += acc0 + acc1;
    pa = (u32x4){cvtpk(s[0], s[1]), cvtpk(s[2], s[3]), cvtpk(s[4], s[5]), cvtpk(s[6], s[7])};
    pb = (u32x4){cvtpk(s[8], s[9]), cvtpk(s[10], s[11]), cvtpk(s[12], s[13]), cvtpk(s[14], s[15])};
}
#define ATT_SB() do {} while (0)
__device__ __forceinline__ void v_frags(bf16x8 (&vf)[4], lds_cptr vp, int eb) {
#pragma unroll
    for (int ks = 0; ks < 4; ++ks) { const s16x4 lo = vtr(vp + (eb >> 1) * 8192 + (eb & 1) * 512 + ks * 2048), hh = vtr(vp + (eb >> 1) * 8192 + (eb & 1) * 512 + ks * 2048 + 1024);
        vf[ks] = (bf16x8){lo[0], lo[1], lo[2], lo[3], hh[0], hh[1], hh[2], hh[3]}; }
}
__device__ __forceinline__ void tile_compute(bool BAND, f32x16 (&O)[4], float& l, const bf16x8 (&q)[4], lds_cptr kp, const int (&ko)[4], lds_cptr vp, const LAS float* bb, int dbase, int pos4) {
    const f32x16 z = {0.f, 0.f, 0.f, 0.f, 0.f, 0.f, 0.f, 0.f, 0.f, 0.f, 0.f, 0.f, 0.f, 0.f, 0.f, 0.f};
    bf16x8 kf[8];
#pragma unroll
    for (int d0 = 0; d0 < 4; ++d0) { kf[d0] = *(const LAS bf16x8*)(kp + ko[d0]); kf[4 + d0] = *(const LAS bf16x8*)(kp + 8192 + ko[d0]); }
    bf16x8 va[4], vb[4];
    v_frags(va, vp, 0);
    __builtin_amdgcn_sched_barrier(0);
    f32x16 s0, s1;
#pragma unroll
    for (int d0 = 0; d0 < 4; ++d0) { s0 = __builtin_amdgcn_mfma_f32_32x32x16_bf16(kf[d0], q[d0], d0 == 0 ? z : s0, 0, 0, 0); s1 = __builtin_amdgcn_mfma_f32_32x32x16_bf16(kf[4 + d0], q[d0], d0 == 0 ? z : s1, 0, 0, 0); }
    u32x4 pa[4];
    if (BAND) { band_fix(s0, bb, dbase, pos4); band_fix(s1, bb, dbase - 32, pos4 + 32); }
    exp_pack(s0, l, pa[0], pa[1]); exp_pack(s1, l, pa[2], pa[3]);
    __builtin_amdgcn_sched_barrier(0);
    v_frags(vb, vp, 1);
#pragma unroll
    for (int ks = 0; ks < 4; ++ks) O[0] = __builtin_amdgcn_mfma_f32_32x32x16_bf16(__builtin_bit_cast(bf16x8, pa[ks]), va[ks], O[0], 0, 0, 0);
    __builtin_amdgcn_sched_barrier(0);
    v_frags(va, vp, 2);
#pragma unroll
    for (int ks = 0; ks < 4; ++ks) O[1] = __builtin_amdgcn_mfma_f32_32x32x16_bf16(__builtin_bit_cast(bf16x8, pa[ks]), vb[ks], O[1], 0, 0, 0);
    __builtin_amdgcn_sched_barrier(0);
    v_frags(vb, vp, 3);
#pragma unroll
    for (int ks = 0; ks < 4; ++ks) O[2] = __builtin_amdgcn_mfma_f32_32x32x16_bf16(__builtin_bit_cast(bf16x8, pa[ks]), va[ks], O[2], 0, 0, 0);
    __builtin_amdgcn_sched_barrier(0);
#pragma unroll
    for (int ks = 0; ks < 4; ++ks) O[3] = __builtin_amdgcn_mfma_f32_32x32x16_bf16(__builtin_bit_cast(bf16x8, pa[ks]), vb[ks], O[3], 0, 0, 0);
}
__device__ __forceinline__ void attn_unit(Frame& F, int b, int h, int qb, float lam, bf16* dst) {
    const int lane = F.lane, r32 = lane & 31, hi = lane >> 5, wid = F.wave, qblk = wid & 3, map = wid >> 2;
    const unsigned lds0 = (unsigned)(uintptr_t)(F.lds + RING_OFF);
    const lds_cptr L = (lds_cptr)(F.lds + RING_OFF);
    const int q0 = qb * 128, qmin = q0 + 32 * qblk, NT = 2 * qb + 3;
    const bf16* Kb = F.K + (size_t)(b * KVROWS) * QKW + h * 128; const bf16* Vb = F.V + (size_t)(b * KVROWS) * DATT + h * 128;
    const bf16* ksrc = Kb + (size_t)(4 * wid + (lane >> 4)) * QKW + (((lane & 15) ^ ((4 * wid + (lane >> 4)) & 15)) * 8);
    const bf16* vsrc = Vb + (size_t)(8 * wid + ((lane >> 2) & 7)) * DATT + (lane >> 5) * 32 + (lane & 3) * 8;
    const unsigned kdst = lds0 + L_K + wid * 1024, vdst = lds0 + L_V + wid * 1024;
#define ATT_DMA(T, slot) do { const size_t go_ = (size_t)(T) * 64 * QKW; const unsigned so_ = (unsigned)(slot) * SLOT; \
        glds16(ksrc + go_, (unsigned)__builtin_amdgcn_readfirstlane(kdst + so_)); glds16(ksrc + go_ + (size_t)32 * QKW, (unsigned)__builtin_amdgcn_readfirstlane(kdst + so_ + 8192)); \
        glds16(vsrc + go_, (unsigned)__builtin_amdgcn_readfirstlane(vdst + so_)); glds16(vsrc + go_ + 64, (unsigned)__builtin_amdgcn_readfirstlane(vdst + so_ + 8192)); } while (0)
    bf16* Qw = F.Q + (size_t)(b * SEQ + qmin + r32) * QKW + h * 128 + map * 64 + hi * 8;
    bf16x8 q[4];
#pragma unroll
    for (int d0 = 0; d0 < 4; ++d0) q[d0] = *(const bf16x8*)(Qw + d0 * 16);
#pragma unroll
    for (int d0 = 0; d0 < 4; ++d0) asm volatile("" : "+v"(q[d0]));
    asm volatile("s_waitcnt lgkmcnt(0)\n\ts_barrier" ::: "memory");
    ATT_DMA(0, 0); ATT_DMA(1, 1); ATT_DMA(2, 2);
    f32x16 O[4];
#pragma unroll
    for (int eb = 0; eb < 4; ++eb)
#pragma unroll
        for (int r = 0; r < 16; ++r) O[eb][r] = 0.f;
    float l = 0.f;
    const LAS float* bb = (const LAS float*)(F.lds + RING_OFF + L_BB) + h * BB_LD;
    const int vlane = ((lane >> 4) & 1) * 32 + (lane & 3) * 8 + (4 * hi + ((lane & 15) >> 2)) * 64;
    int ko[4];
#pragma unroll
    for (int d0 = 0; d0 < 4; ++d0) ko[d0] = r32 * 256 + (((map * 8 + 2 * d0 + hi) ^ (r32 & 15)) * 16);
    const int NTw = (qmin + 95) / 64 + 1 < NT ? (qmin + 95) / 64 + 1 : NT;
#define ATT_STEP_SYNC(T) do { if ((T) + 2 < NT) asm volatile("s_waitcnt vmcnt(8) lgkmcnt(0)\n\ts_barrier" ::: "memory"); \
        else if ((T) + 1 < NT) asm volatile("s_waitcnt vmcnt(4) lgkmcnt(0)\n\ts_barrier" ::: "memory"); \
        else asm volatile("s_waitcnt vmcnt(0) lgkmcnt(0)\n\ts_barrier" ::: "memory"); \
        if ((T) + 3 < NT) ATT_DMA((T) + 3, ((T) + 3) & 3); } while (0)
#pragma clang loop unroll(disable)
    for (int T = 0; T < NTw; ++T) {
        ATT_STEP_SYNC(T);
        const int pos0 = 64 * T - 64;
        const lds_cptr kp = L + L_K + (T & 3) * SLOT, vp = L + L_V + (T & 3) * SLOT + vlane;
        const bool band = !(T >= 1 && pos0 + 63 + 128 <= qmin);
        tile_compute(band, O, l, q, kp, ko, vp, bb, qmin + r32 - pos0 - 4 * hi, pos0 + 4 * hi);
    }
#pragma clang loop unroll(disable)
    for (int T = NTw; T < NT; ++T) ATT_STEP_SYNC(T);
#undef ATT_STEP_SYNC
#undef ATT_DMA
    l += __shfl_xor(l, 32);
    LAS float* wsf = (LAS float*)(F.lds + RING_OFF + L_WS) + wid * 64;
    if (hi == 0) wsf[r32] = (map ? lam : 1.0f) / l;
    asm volatile("s_waitcnt lgkmcnt(0)\n\ts_barrier" ::: "memory");
    float sc[16];
#pragma unroll
    for (int r = 0; r < 16; ++r) sc[r] = wsf[crow(r, hi)];
    LAS float* X = (LAS float*)(F.lds + RING_OFF + L_X) + qblk * 4096 + lane;
    if (map) {
#pragma unroll
        for (int eb = 0; eb < 4; ++eb)
#pragma unroll
            for (int r = 0; r < 16; ++r) X[(eb * 16 + r) * 64] = O[eb][r] * sc[r];
    }
    asm volatile("s_waitcnt lgkmcnt(0)\n\ts_barrier" ::: "memory");
    if (map == 0) {
        float ss[16];
#pragma unroll
        for (int r = 0; r < 16; ++r) { float s = 0.f;
#pragma unroll
            for (int eb = 0; eb < 4; ++eb) { const float o = O[eb][r] * sc[r] - X[(eb * 16 + r) * 64]; O[eb][r] = o; s += o * o; }
            ss[r] = s; }
#pragma unroll
        for (int r = 0; r < 16; ++r) { float s = ss[r]; s += __shfl_xor(s, 1); s += __shfl_xor(s, 2); s += __shfl_xor(s, 4); s += __shfl_xor(s, 8); s += __shfl_xor(s, 16);
            ss[r] = (1.0f - LAMBDA_INIT) / sqrtf(s * (1.0f / VD) + EPS); }
        float sg[4];
#pragma unroll
        for (int eb = 0; eb < 4; ++eb) sg[eb] = F.in[I_SUBG][32 * eb + r32];
        LAS bf16* stg = (LAS bf16*)(F.lds + RING_OFF + L_STG) + qblk * 2048;
        bf16* Ow = dst + (size_t)(b * SEQ + qmin) * QKW + h * 128;
#pragma unroll
        for (int half = 0; half < 2; ++half) {
#pragma unroll
            for (int r = 0; r < 16; ++r) { const int orow = crow(r, hi);
#pragma unroll
                for (int e2 = 0; e2 < 2; ++e2) { const int eb = 2 * half + e2; stg[orow * 64 + e2 * 32 + r32] = (bf16)f2bf(O[eb][r] * ss[r] * sg[eb]); } }
            asm volatile("s_waitcnt lgkmcnt(0)" ::: "memory");
#pragma unroll
            for (int i = 0; i < 4; ++i) { const int row = i * 8 + (lane >> 3), ch = lane & 7; const v4u v = *(const LAS v4u*)(stg + row * 64 + ch * 8); *(v4u*)(Ow + (size_t)row * QKW + half * 64 + ch * 8) = v; }
            asm volatile("s_waitcnt lgkmcnt(0)" ::: "memory");
        }
    }
}
__device__ __forceinline__ void attn_phase(Frame& F, bf16* dst) {
    build_rel_bias_table(F, (LAS float*)(F.lds + RING_OFF + L_BB));
    __syncthreads();
    const float lam = diff_lambda(F);
#pragma clang loop unroll(disable)
    for (int k = 0; ; ++k) { const int pr = F.vcu + (k >> 1) * F.G; if (pr >= BATCH * NH * 16) break;
        const int bh = pr >> 4, j = pr & 15;
        attn_unit(F, bh >> 4, bh & 15, (k & 1) ? j : 31 - j, lam, dst); }
    asm volatile("s_waitcnt vmcnt(0) lgkmcnt(0)" ::: "memory");
    __syncthreads();
}
}
namespace ssm {
constexpr int KM_ELEMS = 66 * 256, T8_ELEMS = 128 * 128, SF_STRIDE = 4608;
constexpr int SF_A = 0, SF_A8 = 128, SF_P64 = 256, SF_BB = 256 + 17 * 128;
static_assert(SF_BB + 64 * 16 * 2 <= SF_STRIDE, "ssm f32 table");
constexpr int L_KM = 0, L_US = 33792, L_SIN = L_US + 2 * 32768, L_END = L_SIN + 32768;
static_assert(KM_ELEMS * 2 <= L_US && L_END <= BIG_BYTES, "ssm LDS map");
typedef float f2 __attribute__((ext_vector_type(2)));
typedef unsigned u2v __attribute__((ext_vector_type(2)));
__device__ __forceinline__ f2 cmul(f2 a, f2 b) { return (f2){a.x * b.x - a.y * b.y, a.x * b.y + a.y * b.x}; }

__device__ __forceinline__ void p0_tables(Frame& F) {
    LAS f2* apw = (LAS f2*)(F.lds + RING_OFF);
    LAS f2* bbl = apw + 65 * 64;
    LAS f2* cl = bbl + 64 * 16;
    for (int gp = F.vcu; gp < NGRP * 4; gp += F.G) {
        const int g = gp >> 2, part = gp & 3;
        const double dt = exp((double)F.in[I_LOGDT][g]);
        __syncthreads();
        if (F.tid < 64) { const int p = F.tid;
            const double lre = F.in[I_LRE][g * 64 + p], lim = F.in[I_LIM][g * 64 + p], er = exp(lre * dt), ar = er * cos(lim * dt), ai = er * sin(lim * dt);
            double pr = 1.0, pi = 0.0, a64r = 1.0, a64i = 0.0;
            for (int n = 0; n <= 64; ++n) { apw[n * 64 + p] = (f2){(float)pr, (float)pi}; a64r = pr; a64i = pi; const double t = pr * ar - pi * ai; pi = pr * ai + pi * ar; pr = t; }
            if (part == 2) { float* sf = F.SSMF + (size_t)g * SF_STRIDE; double qr = 1.0, qi = 0.0;
                for (int n = 0; n <= 16; ++n) { ((f2*)(sf + SF_P64))[n * 64 + p] = (f2){(float)qr, (float)qi}; const double t = qr * a64r - qi * a64i; qi = qr * a64i + qi * a64r; qr = t; } } }
        for (int idx = F.tid; idx < 64 * 16; idx += NWAVES * 64) { const int p = idx >> 4, c = idx & 15;
            const double lre = F.in[I_LRE][g * 64 + p], lim = F.in[I_LIM][g * 64 + p], er = exp(lre * dt), ar = er * cos(lim * dt), ai = er * sin(lim * dt);
            const double nr = ar - 1.0, ni = ai, den = lre * lre + lim * lim, fr = (nr * lre + ni * lim) / den, fi = (ni * lre - nr * lim) / den;
            const double br = F.in[I_BRE][(g * 64 + p) * 16 + c], bi = F.in[I_BIM][(g * 64 + p) * 16 + c];
            bbl[idx] = (f2){(float)(fr * br - fi * bi), (float)(fr * bi + fi * br)}; }
        for (int idx = F.tid; idx < 16 * 64; idx += NWAVES * 64) { const int c = idx >> 6, p = idx & 63; cl[idx] = (f2){F.in[I_CRE][(g * 16 + c) * 64 + p], F.in[I_CIM][(g * 16 + c) * 64 + p]}; }
        __syncthreads();
        bf16* km = F.KM + (size_t)g * KM_ELEMS;
        for (int idx = F.tid; idx < 16 * 256; idx += NWAVES * 64) { const int lag = 16 * part + (idx >> 8), c = (idx >> 4) & 15, c2 = idx & 15; float s = 0.f;
            for (int p = 0; p < 64; ++p) { const f2 z = cmul(cl[c * 64 + p], apw[lag * 64 + p]), b = bbl[p * 16 + c2]; s += z.x * b.x - z.y * b.y; }
            km[(lag + 2) * 256 + c * 16 + c2] = (bf16)f2bf(s); }
        if (part == 0) { for (int idx = F.tid; idx < 512; idx += NWAVES * 64) km[idx] = 0;
            bf16* w8 = F.W8 + (size_t)g * T8_ELEMS;
            for (int idx = F.tid; idx < T8_ELEMS; idx += NWAVES * 64) { const int row = idx >> 7, col = idx & 127, p = row >> 1, ri = row & 1, i2 = col >> 4, c2 = col & 15;
                const f2 z = cmul(apw[(7 - i2) * 64 + p], bbl[p * 16 + c2]); w8[idx] = (bf16)f2bf(ri ? z.y : z.x); } }
        if (part == 1) { bf16* g8 = F.G8 + (size_t)g * T8_ELEMS;
            for (int idx = F.tid; idx < T8_ELEMS; idx += NWAVES * 64) { const int row = idx >> 7, col = idx & 127, j2 = row >> 4, c = row & 15, p = col >> 1, ri = col & 1;
                const f2 z = cmul(cl[c * 64 + p], apw[(j2 + 1) * 64 + p]); g8[idx] = (bf16)f2bf(ri ? -z.y : z.x); } }
        if (part == 2) { float* sf = F.SSMF + (size_t)g * SF_STRIDE;
            for (int p = F.tid; p < 64; p += NWAVES * 64) { ((f2*)(sf + SF_A))[p] = apw[1 * 64 + p]; ((f2*)(sf + SF_A8))[p] = apw[8 * 64 + p]; }
            for (int idx = F.tid; idx < 64 * 16; idx += NWAVES * 64) ((f2*)(sf + SF_BB))[idx] = bbl[idx]; }
    }
    __syncthreads();
}

__device__ __forceinline__ void glds16(const void* gsrc, unsigned lds_dst) { unsigned keep;
    asm volatile("s_mov_b32 %0, m0\n\ts_mov_b32 m0, %2\n\ts_nop 0\n\tglobal_load_lds_dwordx4 %1, off\n\ts_mov_b32 m0, %0" : "=&s"(keep) : "v"(gsrc), "s"(lds_dst) : "memory"); }
__device__ __forceinline__ float shfl_up16(float v, int d, int l15) { const float t = __shfl_up(v, d, 16); return l15 >= d ? t : 0.f; }

__device__ __forceinline__ void ssm_unit(Frame& F, int g, int b) {
    const int lane = F.lane, w = F.wave, l15 = lane & 15, kq = lane >> 4;
    const unsigned lds0 = (unsigned)(uintptr_t)(F.lds + RING_OFF);
    LAS const char* L = (LAS const char*)(F.lds + RING_OFF);
    __syncthreads();
    { const v4u* kmg = (const v4u*)(F.KM + (size_t)g * KM_ELEMS); LAS v4u* kml = (LAS v4u*)(F.lds + RING_OFF + L_KM);
      for (int i = F.tid; i < KM_ELEMS / 8; i += NWAVES * 64) kml[i] = kmg[i]; }
    const bf16* usrc = F.U + ((size_t)(b * SEQ) + ((lane >> 1) & 15) * 64 + (lane >> 5)) * D_SSM + g * 16 + (lane & 1) * 8;
#define SSM_SLAB(nt, buf) do { _Pragma("unroll") for (int r_ = 0; r_ < 4; ++r_) { const int q_ = w * 4 + r_; \
        glds16(usrc + ((size_t)(nt) * 1024 + 2 * q_) * D_SSM, (unsigned)__builtin_amdgcn_readfirstlane(lds0 + L_US + (buf) * 32768 + q_ * 1024)); } } while (0)
    SSM_SLAB(0, 0);
    const float* sf = F.SSMF + (size_t)g * SF_STRIDE;
    const int pa = 8 * w + 2 * kq;
    const f2 a8a = ((const f2*)(sf + SF_A8))[pa], a8b = ((const f2*)(sf + SF_A8))[pa + 1];
    const f2* p64 = (const f2*)(sf + SF_P64);
    const f2 pna = p64[l15 * 64 + pa], pnb = p64[l15 * 64 + pa + 1], p16a = p64[16 * 64 + pa], p16b = p64[16 * 64 + pa + 1];
    bf16x8 w8f[4], g8f[4];
#pragma unroll
    for (int ks = 0; ks < 4; ++ks) { w8f[ks] = *(const bf16x8*)(F.W8 + (size_t)g * T8_ELEMS + (16 * w + l15) * 128 + 32 * ks + 8 * kq);
                                     g8f[ks] = *(const bf16x8*)(F.G8 + (size_t)g * T8_ELEMS + (16 * w + l15) * 128 + 32 * ks + 8 * kq); }
    const f32x4 dsk = *(const f32x4*)(F.in[I_DSKIP] + g * 16 + 4 * kq);
    f2 s0a = {0.f, 0.f}, s0b = {0.f, 0.f};
    { const f2 aa = ((const f2*)(sf + SF_A))[pa], ab = ((const f2*)(sf + SF_A))[pa + 1]; const f2* bba = (const f2*)(sf + SF_BB) + pa * 16; const f2* bbb = bba + 16;
      const v4u mu0 = *(const v4u*)(F.UM + l15 * D_SSM + g * 16), mu1 = *(const v4u*)(F.UM + l15 * D_SSM + g * 16 + 8);
      f2 bva[16], bvb[16];
#pragma unroll
      for (int c = 0; c < 16; ++c) { bva[c] = bba[c]; bvb[c] = bbb[c]; }
#pragma unroll
      for (int j = 0; j < NMETA; ++j) {
          const unsigned x0 = __builtin_amdgcn_readlane(mu0.x, j), x1 = __builtin_amdgcn_readlane(mu0.y, j), x2 = __builtin_amdgcn_readlane(mu0.z, j), x3 = __builtin_amdgcn_readlane(mu0.w, j);
          const unsigned x4 = __builtin_amdgcn_readlane(mu1.x, j), x5 = __builtin_amdgcn_readlane(mu1.y, j), x6 = __builtin_amdgcn_readlane(mu1.z, j), x7 = __builtin_amdgcn_readlane(mu1.w, j);
          float u[16];
          u[0] = bf_lo(x0); u[1] = bf_hi(x0); u[2] = bf_lo(x1); u[3] = bf_hi(x1); u[4] = bf_lo(x2); u[5] = bf_hi(x2); u[6] = bf_lo(x3); u[7] = bf_hi(x3);
          u[8] = bf_lo(x4); u[9] = bf_hi(x4); u[10] = bf_lo(x5); u[11] = bf_hi(x5); u[12] = bf_lo(x6); u[13] = bf_hi(x6); u[14] = bf_lo(x7); u[15] = bf_hi(x7);
          f2 ba = {0.f, 0.f}, bb_ = {0.f, 0.f};
#pragma unroll
          for (int c = 0; c < 16; ++c) { ba += bva[c] * u[c]; bb_ += bvb[c] * u[c]; }
          s0a = cmul(aa, s0a) + ba; s0b = cmul(ab, s0b) + bb_; } }
    const int boff = (kq >> 1) * 512 + l15 * 32 + (kq & 1) * 16;
    const int aoff = L_KM + (32 - (kq >> 1) * 16 + l15) * 32 + (kq & 1) * 16;
    const int soff = L_SIN + ((2 * w + (kq >> 1)) * 16 + l15) * 16 + (kq & 1) * 8;
    const int sfrag = L_SIN + (kq * 16 + l15) * 16;
    for (int nt = 0; nt < 4; ++nt) {
        asm volatile("s_waitcnt vmcnt(0) lgkmcnt(0)\n\ts_barrier" ::: "memory");
        if (nt + 1 < 4) SSM_SLAB(nt + 1, (nt + 1) & 1);
        const LAS char* slab = L + L_US + (nt & 1) * 32768;
        f2 ea, eb;
#pragma unroll
        for (int s = 0; s < 8; ++s) { f32x4 acc = {0.f, 0.f, 0.f, 0.f};
            bf16x8 bfs[4];
#pragma unroll
            for (int ks = 0; ks < 4; ++ks) bfs[ks] = *(const LAS bf16x8*)(slab + (8 * s + 2 * ks) * 512 + boff);
#pragma unroll
            for (int ks = 0; ks < 4; ++ks) acc = __builtin_amdgcn_mfma_f32_16x16x32_bf16(w8f[ks], bfs[ks], acc, 0, 0, 0);
            if (s == 0) { ea = (f2){acc[0], acc[1]}; eb = (f2){acc[2], acc[3]}; }
            else { ea = cmul(ea, a8a) + (f2){acc[0], acc[1]}; eb = cmul(eb, a8b) + (f2){acc[2], acc[3]}; } }
#pragma unroll
        for (int d = 1; d < 16; d <<= 1) { const f2 wa = p64[d * 64 + pa], wb = p64[d * 64 + pa + 1];
            const f2 qa = {shfl_up16(ea.x, d, l15), shfl_up16(ea.y, d, l15)}, qb = {shfl_up16(eb.x, d, l15), shfl_up16(eb.y, d, l15)};
            ea += cmul(wa, qa); eb += cmul(wb, qb); }
        f2 sa = cmul(pna, s0a) + (f2){shfl_up16(ea.x, 1, l15), shfl_up16(ea.y, 1, l15)};
        f2 sb = cmul(pnb, s0b) + (f2){shfl_up16(eb.x, 1, l15), shfl_up16(eb.y, 1, l15)};
        { const int src = (lane & 48) | 15;
          const f2 la = {__shfl(ea.x, src), __shfl(ea.y, src)}, lb = {__shfl(eb.x, src), __shfl(eb.y, src)};
          s0a = cmul(p16a, s0a) + la; s0b = cmul(p16b, s0b) + lb; }
#pragma unroll
        for (int s = 0; s < 8; ++s) {
            u2v o; o.x = pk2(sa.x, sa.y); o.y = pk2(sb.x, sb.y);
            *(LAS u2v*)(F.lds + RING_OFF + soff + s * 4096) = o;
            sa = cmul(sa, a8a); sb = cmul(sb, a8b); }
        asm volatile("s_waitcnt lgkmcnt(0)\n\ts_barrier" ::: "memory");
        f32x4 acc[8];
#pragma unroll
        for (int jj = 0; jj < 8; ++jj) acc[jj] = (f32x4){0.f, 0.f, 0.f, 0.f};
#pragma unroll 2
        for (int ks = 0; ks < 32; ++ks) { const int i0 = 2 * ks;
            const bf16x8 bf = *(const LAS bf16x8*)(slab + i0 * 512 + boff);
            bf16x8 af[8];
#pragma unroll
            for (int jj = 0; jj < 8; ++jj) { int d = w + 8 * jj - i0; d = d < -1 ? -1 : d; af[jj] = *(const LAS bf16x8*)(L + aoff + d * 512); }
#pragma unroll
            for (int jj = 0; jj < 8; ++jj) acc[jj] = __builtin_amdgcn_mfma_f32_16x16x32_bf16(af[jj], bf, acc[jj], 0, 0, 0); }
#pragma unroll
        for (int jj = 0; jj < 8; ++jj)
#pragma unroll
            for (int ks = 0; ks < 4; ++ks) { const bf16x8 bf = *(const LAS bf16x8*)(L + sfrag + jj * 4096 + ks * 1024); acc[jj] = __builtin_amdgcn_mfma_f32_16x16x32_bf16(g8f[ks], bf, acc[jj], 0, 0, 0); }
#pragma unroll
        for (int jj = 0; jj < 8; ++jj) { const int j = w + 8 * jj;
            const u2v uu = *(const LAS u2v*)(slab + j * 512 + l15 * 32 + kq * 8);
            const float y0 = acc[jj][0] + dsk[0] * bf_lo(uu.x), y1 = acc[jj][1] + dsk[1] * bf_hi(uu.x), y2 = acc[jj][2] + dsk[2] * bf_lo(uu.y), y3 = acc[jj][3] + dsk[3] * bf_hi(uu.y);
            u2v o; o.x = pk2(gelu_tanh(y0), gelu_tanh(y1)); o.y = pk2(gelu_tanh(y2), gelu_tanh(y3));
            *(u2v*)(F.Gb + ((size_t)(b * SEQ) + nt * 1024 + l15 * 64 + j) * D_SSM + g * 16 + 4 * kq) = o; }
    }
#undef SSM_SLAB
    asm volatile("s_waitcnt vmcnt(0) lgkmcnt(0)" ::: "memory");
    __syncthreads();
}
__device__ __forceinline__ void ssm_phase(Frame& F) {
    for (int un = F.vcu; un < NGRP * BATCH; un += F.G) ssm_unit(F, un >> 2, un & 3);
}
}
#ifndef PROBE_MASK
#define PROBE_MASK 0xff
#endif
#define PROBE_PH(k) (((PROBE_MASK) >> (k)) & 1)
struct Args { const float* in[27]; float* out; unsigned char* ws; int ph_lo, ph_hi, li, pad; };
__global__ void __launch_bounds__(NWAVES * 64, 2) mk_fwd(Args args) {
    extern __shared__ __attribute__((aligned(16))) unsigned char lds[];
    Frame F;
    F.lds = (LAS unsigned char*)lds;
    F.MISC = (volatile LAS unsigned*)(F.lds + MISC_OFF);
    F.tid = threadIdx.x; F.lane = F.tid & 63; F.wave = __builtin_amdgcn_readfirstlane(F.tid >> 6);
    F.G = gridDim.x; { const int bx = blockIdx.x; F.vcu = (F.G % 8 == 0) ? (bx % 8) * (F.G / 8) + bx / 8 : bx; }
    unsigned char* ws = args.ws; F.ws = ws; F.out = args.out;
#pragma unroll
    for (int i = 0; i < 27; ++i) F.in[i] = args.in[i];
    F.ctl = (gu32*)(ws + WS_CTL);
    F.WinT = (bf16*)(ws + WS_WIN); F.WgluT = (bf16*)(ws + WS_WGLU); F.WbraT = (bf16*)(ws + WS_WBRA); F.WbrbT = (bf16*)(ws + WS_WBRB); F.WoT = (bf16*)(ws + WS_WO); F.WguT = (bf16*)(ws + WS_WGU); F.WdnT = (bf16*)(ws + WS_WDN);
    F.HN = (bf16*)(ws + WS_HN); F.TM = (bf16*)(ws + WS_TM); F.U = (bf16*)(ws + WS_U); F.Q = (bf16*)(ws + WS_Q); F.K = (bf16*)(ws + WS_K); F.V = (bf16*)(ws + WS_V); F.GS = (bf16*)(ws + WS_GS); F.GA = (bf16*)(ws + WS_GA);
    F.ACT = (bf16*)(ws + WS_ACT); F.Gb = (bf16*)(ws + WS_G); F.YSSM = (bf16*)(ws + WS_YSSM); F.HNM = (bf16*)(ws + WS_HNM); F.UM = (bf16*)(ws + WS_UM); F.PS = (float*)(ws + WS_PS);
    F.KM = (bf16*)(ws + WS_KM); F.W8 = (bf16*)(ws + WS_W8); F.G8 = (bf16*)(ws + WS_G8); F.SSMF = (float*)(ws + WS_SSMF);
    for (int u = F.tid; u < (LDS_BYTES - LDSCTL_OFF) / 4; u += NWAVES * 64) ((LAS unsigned*)(F.lds + LDSCTL_OFF))[u] = 0u;
    __syncthreads();
    XcdBarrier bar; bar.bar = (unsigned*)(F.ctl + CW_BAR); bar.x = 0; bar.st = nullptr;
    if (N_LAUNCHES == 1) bar = xcd_barrier_post((unsigned*)(F.ctl + CW_BAR), F.MISC + 8);
#define GRID_BAR(seam) do { if (N_LAUNCHES != 1) { if (F.tid == 0) __hip_atomic_store(F.ctl + CW_TMO, 0xBADBA0u | (unsigned)(seam), RLX_AGENT); } else { xcd_barrier(bar); } } while (0)
    const int lo = args.ph_lo, hi = args.ph_hi;
#define IN(k) (lo <= (k) && (k) < hi)
#define BOTH(k) (IN(k) && IN((k) + 1))
    using namespace pg8;
#define PHASE_0() do { const int g3_ = ((int)blockIdx.x >> 3) % 3; if (g3_ == 0) ssm::p0_tables(F); p0_prologue(F, 1); if (g3_ == 1) ssm::p0_tables(F); p0_prologue(F, 2); if (g3_ == 2) ssm::p0_tables(F); } while (0)
#define PHASE_1() do { \
        Gemm g{F.HN, F.WinT, M, D_IN, D}; StaticOrder S; S.init(M, D_IN, F.G, (int)blockIdx.x); \
        EpiInProj E{F.U, F.Q, F.K, F.V, F.GS, F.GA, F.in[I_QG], F.in[I_KG]}; \
        gemm_phase<EpiInProj, StaticOrder, PG8_ALIGN, PG8_SP2>(F.lds + RING_OFF, g, S, E); if (F.tid == 0) (void)__hip_atomic_fetch_add(F.ctl + CW_ARR1, 1u, RLX_AGENT); meta_proj(F); pull_rest_items(F, 1); } while (0)
#define PHASE_2() do { att::attn_phase(F, F.Q); if (((int)blockIdx.x >> 3) & 1) pull_rest_half(F); ssm::ssm_phase(F); pull_rest_items(F, 0); } while (0)
#define PHASE_3() do { \
        { Gemm g{F.Gb, F.WgluT, M, D_SSM, D_SSM}; StaticOrder S; S.init(M, D_SSM, F.G, (int)blockIdx.x); \
          EpiGlu E{F.Gb, F.in[I_BGLU], F.YSSM}; \
          gemm_phase<EpiGlu, StaticOrder, PG8_ALIGN, PG8_SP2>(F.lds + RING_OFF, g, S, E); } \
        { Gemm g{F.Q, F.WbrbT, M, D, DATT}; StaticOrder S; S.init(M, D, F.G, (int)blockIdx.x); \
          EpiBranch<true> E{F.GA, F.TM}; \
          gemm_phase<EpiBranch<true>, StaticOrder, PG8_ALIGN, PG8_SP2>(F.lds + RING_OFF, g, S, E); } } while (0)
#define PHASE_4() do { Gemm g{F.YSSM, F.WbraT, M, D, D_SSM}; StaticOrder S; S.init(M, D, F.G, (int)blockIdx.x); \
        EpiBranch<false> E{F.GS, F.TM}; \
        gemm_phase<EpiBranch<false>, StaticOrder, PG8_ALIGN, PG8_SP2>(F.lds + RING_OFF, g, S, E); } while (0)
#define PHASE_5() do { Gemm g{F.TM, F.WoT, M, D, D}; StaticOrder S; S.init(M, D, F.G, (int)blockIdx.x); \
        EpiOut E{F.in[I_X], F.HN, F.PS}; \
        gemm_phase<EpiOut, StaticOrder, PG8_ALIGN, PG8_SP2>(F.lds + RING_OFF, g, S, E); } while (0)
#define PHASE_6() do { Gemm g{F.HN, F.WguT, M, 2 * D_FF, D}; TailOrder S; S.init(M, 2 * D_FF, F.G, (int)blockIdx.x); \
        S.q = (unsigned*)(F.ctl + CW_QTAIL); S.slot = (volatile PG8_LAS unsigned*)(F.MISC + 15); S.tail = S.nwg / F.G; \
        EpiGateUp E{F.PS, F.ACT}; \
        gemm_phase<EpiGateUp, TailOrder, PG8_ALIGN, PG8_SP2>(F.lds + RING_OFF, g, S, E); \
        pull_wdown_items(F); } while (0)
#define PHASE_7() do { Gemm g{F.ACT, F.WdnT, M, D, D_FF}; ARowOnceOrder S; S.init(M, D, F.G, (int)blockIdx.x); \
        EpiDown E{F.HN, F.out}; \
        gemm_phase<EpiDown, ARowOnceOrder, PG8_ALIGN, PG8_SP2>(F.lds + RING_OFF, g, S, E); } while (0)
#ifndef PROBE_CLOCK
#define PROBE_CLOCK 0
#endif
#ifndef PROBE_REP
#define PROBE_REP 0
#endif
    if (IN(0)) { PHASE_0(); if (PROBE_REP & 1) { GRID_BAR(0); PHASE_0(); } if (BOTH(0)) GRID_BAR(0); }
    if (IN(1)) { PHASE_1(); if (PROBE_REP & 2) { GRID_BAR(1); PHASE_1(); } if (BOTH(1)) GRID_BAR(1); }
    if (IN(2)) { PHASE_2(); if (PROBE_REP & 256) { ssm::ssm_phase(F); } if (PROBE_REP & 4) { GRID_BAR(2); PHASE_1(); GRID_BAR(2); PHASE_2(); } if (BOTH(2)) GRID_BAR(2); }
    if (IN(3)) { PHASE_3(); if (PROBE_REP & 8) { GRID_BAR(3); PHASE_3(); } if (BOTH(3)) GRID_BAR(3); }
    if (IN(4)) { PHASE_4(); if (PROBE_REP & 16) { GRID_BAR(4); PHASE_3(); GRID_BAR(4); PHASE_4(); } if (BOTH(4)) GRID_BAR(4); }
    if (IN(5) && (PROBE_REP & 2048)) { GRID_BAR(5); GRID_BAR(5); GRID_BAR(5); GRID_BAR(5); GRID_BAR(5); GRID_BAR(5); GRID_BAR(5); GRID_BAR(5); }
    if (IN(5) && (PROBE_REP & 1024)) { Gemm g{F.TM, F.WoT, M, D, D}; StaticOrder S; S.init(M, D, F.G, (int)blockIdx.x);
        EpiOut E{F.in[I_X], F.HN, F.PS};
        gemm_phase<EpiOut, StaticOrder, PG8_ALIGN, PG8_SP2, true>(F.lds + RING_OFF, g, S, E); GRID_BAR(5); }
    if (IN(5)) { PHASE_5(); if (PROBE_REP & 32) { GRID_BAR(5); PHASE_5(); } if (BOTH(5)) GRID_BAR(5); }
#if PROBE_CLOCK
    long long pc0_ = 0; unsigned long long pr0_ = 0;
    if (IN(6)) { pc0_ = clock64(); pr0_ = __builtin_amdgcn_s_memrealtime(); }
#endif
    if (IN(6)) { PHASE_6(); if (PROBE_REP & 64) { GRID_BAR(6); PHASE_5(); GRID_BAR(6); PHASE_6(); } if (BOTH(6)) GRID_BAR(6); }
#if PROBE_CLOCK
    if (IN(6) && blockIdx.x == 0 && F.tid == 0) { const long long dc_ = clock64() - pc0_; const unsigned long long dr_ = __builtin_amdgcn_s_memrealtime() - pr0_;
        F.ctl[CW_CODE + 8] = (unsigned)((double)dc_ * 100.0 / (double)dr_); }
#endif
    if (IN(7)) { PHASE_7(); if (PROBE_REP & 128) { GRID_BAR(7); PHASE_5(); GRID_BAR(7); PHASE_6(); GRID_BAR(7); PHASE_7(); } }
#if PROBE_CLOCK
    if (IN(7)) { GRID_BAR(7); if (blockIdx.x == 0 && F.tid == 0) { const unsigned mhz_ = __hip_atomic_load(F.ctl + CW_CODE + 8, RLX_AGENT); F.out[0] += (float)((int)mhz_ - PROBE_CLOCK); } }
#endif
#undef IN
#undef BOTH
}

extern "C" void kernel_launch(void* const* d_in, const int* in_sizes, int n_in, void* d_out, int out_size, void* d_ws, size_t ws_size, hipStream_t stream) {
    static int grid = 0;
    if (grid == 0) {
        if (n_in != 27 || in_sizes[0] != M * D || out_size != M * D || ws_size < WS_END) { fprintf(stderr, "kernel_launch: built for 27 inputs, x and out of %d floats, >= %zu bytes of workspace; got n_in %d, in0 %d, out %d, ws %zu; nothing launched\n", M * D, (size_t)WS_END, n_in, n_in > 0 ? in_sizes[0] : -1, out_size, ws_size); grid = -1; return; }
        int dev = 0, cus = 0, per_cu = 0;
        if (hipGetDevice(&dev) != hipSuccess || hipDeviceGetAttribute(&cus, hipDeviceAttributeMultiprocessorCount, dev) != hipSuccess) { fprintf(stderr, "kernel_launch: hipGetDevice / hipDeviceGetAttribute failed; nothing launched\n"); grid = -1; return; }
        if (hipFuncSetAttribute((const void*)mk_fwd, hipFuncAttributeMaxDynamicSharedMemorySize, LDS_BYTES) != hipSuccess) { fprintf(stderr, "kernel_launch: hipFuncSetAttribute failed; nothing launched\n"); grid = -1; return; }
        if (hipOccupancyMaxActiveBlocksPerMultiprocessor(&per_cu, (const void*)mk_fwd, NWAVES * 64, LDS_BYTES) != hipSuccess || per_cu < 1)
            fprintf(stderr, "kernel_launch: note: the occupancy query reports %d workgroups per CU\n", per_cu);
        (void)hipGetLastError();
        grid = cus;
    }
    if (grid < 0) return;
    if (hipMemsetAsync((char*)d_ws + WS_CTL, 0, CTL_ZERO_BYTES, stream) != hipSuccess) { fprintf(stderr, "kernel_launch: hipMemsetAsync of the control words failed; nothing launched\n"); return; }
    Args a{};
    for (int i = 0; i < 27; ++i) a.in[i] = (const float*)d_in[i];
    a.out = (float*)d_out; a.ws = (unsigned char*)d_ws;
    for (int li = 0; li < N_LAUNCHES; ++li) {
        a.ph_lo = (N_LAUNCHES == 1) ? 0 : li; a.ph_hi = (N_LAUNCHES == 1) ? N_PHASES : li + 1; a.li = li;
        hipLaunchKernelGGL(mk_fwd, dim3(grid), dim3(NWAVES * 64), LDS_BYTES, stream, a);
        const hipError_t le = hipPeekAtLastError();
        if (le != hipSuccess) { fprintf(stderr, "kernel_launch: launch %d failed: %s (grid %d x %d threads, %d B LDS)\n", li, hipGetErrorName(le), grid, NWAVES * 64, LDS_BYTES); break; }
    }
}
```
